# Optimizing an MI355X kernel written in HIP

```python
import math
import jax, jax.numpy as jnp
from jax import lax
import numpy as np

D_MODEL = 1024
BATCH = 16
SEQ = 2048
DEPTH = 2

HEAD_DIM = 64
ATTN_SCALE = HEAD_DIM ** -0.5
N_HEADS_A = 8
DIL_PATTERNS = ((128, 1), (512, 4), (2048, 16))
WIDTH_A = N_HEADS_A * HEAD_DIM
N_HEADS_B = 4
WIDTH_B = N_HEADS_B * 2 * HEAD_DIM
MIX_WIDTH = WIDTH_A + WIDTH_B
PROJ_WIDTH = 3 * MIX_WIDTH
N_REL_HEADS = N_HEADS_A + N_HEADS_B
N_BUCKETS = 32
MAX_DISTANCE = 128
Q_BLOCK = 128
D_FF = 2816
N_EXPERTS = 8
TOP_K = 2
D_FF_EXPERT = 3584
EXPERT_BLOCK = 512
N_DENSE = (DEPTH + 1) // 2
N_MOE = DEPTH // 2
EPS = 1e-6

kernel_name = "hybrid_dilated_diff_attn_moe_block"


def rms_norm(x, g):
    xf = x.astype(jnp.float32)
    y = xf * lax.rsqrt(jnp.mean(xf * xf, axis=-1, keepdims=True) + EPS)
    return (y * g.astype(jnp.float32)).astype(x.dtype)


def t5_bucket(dist):
    n = jnp.maximum(dist, 0)
    max_exact = N_BUCKETS // 2
    large = max_exact + (jnp.log(jnp.maximum(n, 1).astype(jnp.float32) / max_exact)
                         / math.log(MAX_DISTANCE / max_exact) * (N_BUCKETS - max_exact)).astype(jnp.int32)
    large = jnp.minimum(large, N_BUCKETS - 1)
    return jnp.where(n < max_exact, n, large)


def dilated_branch(q, k, v, bias_tab, window, dil):
    b, h, s, hd = q.shape
    blk = window // dil
    L = s // dil
    nb = -(-L // blk)
    Lp = nb * blk

    def to_sub(t):
        t = t.reshape(b, h, L, dil, hd).transpose(0, 1, 3, 2, 4)
        t = jnp.pad(t, ((0, 0), (0, 0), (0, 0), (0, Lp - L), (0, 0)))
        return t.reshape(b, h, dil, nb, blk, hd)

    def with_prev(t):
        prev = jnp.pad(t, ((0, 0), (0, 0), (0, 0), (1, 0), (0, 0), (0, 0)))[:, :, :, :-1]
        return jnp.concatenate([prev, t], axis=4)

    qs = to_sub(q)
    kb = with_prev(to_sub(k))
    vb = with_prev(to_sub(v))
    i = jnp.arange(blk)[:, None]
    j = jnp.arange(2 * blk)[None, :]
    steps = blk + i - j
    band = (steps >= 0) & (steps <= blk)
    has_prev = (jnp.arange(nb) > 0)[:, None, None] | (j >= blk)[None]
    valid = band[None] & has_prev
    bias = jnp.transpose(bias_tab[t5_bucket(steps * dil)], (2, 0, 1)).astype(jnp.float32)
    logits = jnp.einsum('bhrnqd,bhrnkd->bhrnqk', qs, kb,
                        preferred_element_type=jnp.float32) * ATTN_SCALE + bias[None, :, None, None]
    logits = jnp.where(valid[None, None, None], logits, -jnp.inf)
    lse = jax.scipy.special.logsumexp(logits, axis=-1)
    p = jnp.exp(logits - lse[..., None])
    out = jnp.einsum('bhrnqk,bhrnkd->bhrnqd', p.astype(v.dtype), vb)
    out = out.reshape(b, h, dil, Lp, hd)[:, :, :, :L].transpose(0, 1, 3, 2, 4).reshape(b, h, s, hd)
    lse = lse.reshape(b, h, dil, Lp)[:, :, :, :L].transpose(0, 1, 3, 2).reshape(b, h, s)
    return out, lse


def dilated_attention(q, k, v, bias_tab):
    outs, lses = [], []
    for window, dil in DIL_PATTERNS:
        o, l = dilated_branch(q, k, v, bias_tab, window, dil)
        outs.append(o)
        lses.append(l)
    w = jax.nn.softmax(jnp.stack(lses, axis=0), axis=0)
    o = jnp.stack(outs, axis=0).astype(jnp.float32)
    return jnp.sum(w[..., None] * o, axis=0).astype(q.dtype)


def diff_attention(q1, q2, k1, k2, v, bias_tab, lam, lam_init, subln_g):
    b, h, s, hd = q1.shape
    nq = s // Q_BLOCK
    kpos = jnp.arange(s)

    def blockify(t):
        return jnp.moveaxis(t.reshape(b, h, nq, Q_BLOCK, hd), 2, 0)

    def one_block(args):
        qb1, qb2, bi = args
        qpos = bi * Q_BLOCK + jnp.arange(Q_BLOCK)
        dist = qpos[:, None] - kpos[None, :]
        bias = jnp.moveaxis(bias_tab[t5_bucket(dist)], -1, 0).astype(jnp.float32)
        causal = dist >= 0

        def attn_map(qb, kk):
            logits = jnp.einsum('bhqd,bhkd->bhqk', qb, kk,
                                preferred_element_type=jnp.float32) * ATTN_SCALE + bias
            return jax.nn.softmax(jnp.where(causal, logits, -jnp.inf), axis=-1)

        a = attn_map(qb1, k1) - lam * attn_map(qb2, k2)
        return jnp.einsum('bhqk,bhkd->bhqd', a.astype(v.dtype), v)

    out = lax.map(one_block, (blockify(q1), blockify(q2), jnp.arange(nq)))
    out = jnp.moveaxis(out, 0, 2).reshape(b, h, s, 2 * hd)
    return rms_norm(out, subln_g) * (1.0 - lam_init)


def hybrid_mixer(xn, w_in, w_out, q_norm_a, k_norm_a, q_norm_b, k_norm_b,
                 lq1, lk1, lq2, lk2, subln_g, rel_bias, layer):
    b, s, _ = xn.shape
    proj = xn @ w_in
    qa, ka, va, qb, kb, vb = jnp.split(
        proj, [WIDTH_A, 2 * WIDTH_A, 3 * WIDTH_A, 3 * WIDTH_A + WIDTH_B, 3 * WIDTH_A + 2 * WIDTH_B], axis=-1)

    def heads_a(t):
        return t.reshape(b, s, N_HEADS_A, HEAD_DIM).transpose(0, 2, 1, 3)
    qa = rms_norm(heads_a(qa), q_norm_a)
    ka = rms_norm(heads_a(ka), k_norm_a)
    oa = dilated_attention(qa, ka, heads_a(va), rel_bias[:, :N_HEADS_A])

    def halves_b(t):
        return t.reshape(b, s, N_HEADS_B, 2, HEAD_DIM).transpose(3, 0, 2, 1, 4)
    qb = rms_norm(halves_b(qb), q_norm_b)
    kb = rms_norm(halves_b(kb), k_norm_b)
    vb = vb.reshape(b, s, N_HEADS_B, 2 * HEAD_DIM).transpose(0, 2, 1, 3)
    lam_init = 0.8 - 0.6 * math.exp(-0.3 * layer)
    f32 = jnp.float32
    lam = (jnp.exp(jnp.sum(lq1.astype(f32) * lk1.astype(f32)))
           - jnp.exp(jnp.sum(lq2.astype(f32) * lk2.astype(f32))) + lam_init)
    ob = diff_attention(qb[0], qb[1], kb[0], kb[1], vb, rel_bias[:, N_HEADS_A:], lam, lam_init, subln_g)

    oa = oa.transpose(0, 2, 1, 3).reshape(b, s, WIDTH_A)
    ob = ob.transpose(0, 2, 1, 3).reshape(b, s, WIDTH_B)
    return jnp.concatenate([oa, ob], axis=-1) @ w_out


def swiglu(x, w_gate, w_up, w_down):
    return (jax.nn.silu(x @ w_gate) * (x @ w_up)) @ w_down


def moe_swiglu(x, w_router, w_gate, w_up, w_down):
    b, s, d = x.shape
    xt = x.reshape(-1, d)
    n = xt.shape[0]
    logits = jnp.dot(xt, w_router, preferred_element_type=jnp.float32)
    top_val, top_idx = lax.top_k(logits, TOP_K)
    gates = jax.nn.softmax(top_val, axis=-1)
    e_flat = top_idx.reshape(-1)
    g_flat = gates.reshape(-1)
    tok_flat = jnp.arange(n * TOP_K) // TOP_K
    order = jnp.argsort(e_flat)
    e_sorted = e_flat[order]
    tok_sorted = tok_flat[order]
    g_sorted = g_flat[order]
    counts = jnp.zeros((N_EXPERTS,), jnp.int32).at[e_flat].add(1)
    starts = jnp.cumsum(counts) - counts
    padded = (counts + EXPERT_BLOCK - 1) // EXPERT_BLOCK * EXPERT_BLOCK
    pad_ends = jnp.cumsum(padded)
    pad_starts = pad_ends - padded
    dest = pad_starts[e_sorted] + jnp.arange(n * TOP_K) - starts[e_sorted]
    n_blocks = -(-(n * TOP_K) // EXPERT_BLOCK) + N_EXPERTS
    x_pad = jnp.zeros((n_blocks * EXPERT_BLOCK, d), x.dtype).at[dest].set(xt[tok_sorted])
    block_expert = jnp.minimum(
        jnp.searchsorted(pad_ends, jnp.arange(n_blocks) * EXPERT_BLOCK, side='right'), N_EXPERTS - 1)

    def expert_block(args):
        xb, e = args
        return swiglu(xb, w_gate[e], w_up[e], w_down[e])

    y_pad = lax.map(expert_block, (x_pad.reshape(n_blocks, EXPERT_BLOCK, d), block_expert))
    y_sorted = y_pad.reshape(-1, d)[dest]
    out = jnp.zeros((n, d), x.dtype).at[tok_sorted].add(y_sorted * g_sorted[:, None].astype(x.dtype))
    return out.reshape(b, s, d)


def setup_inputs(seed: int = 0) -> dict:
    key = jax.random.key(seed)
    ks = jax.random.split(key, 24)
    f32 = jnp.float32

    def nrm(k, shape, scale):
        return jax.random.normal(k, shape, f32) * scale

    def gain(k, shape):
        return 1.0 + 0.02 * jax.random.normal(k, shape, f32)

    return {
        "x": nrm(ks[0], (BATCH, SEQ, D_MODEL), 1.0),
        "norm_mix_g": gain(ks[1], (DEPTH, D_MODEL)),
        "norm_ffn_g": gain(ks[2], (DEPTH, D_MODEL)),
        "w_in": nrm(ks[3], (DEPTH, D_MODEL, PROJ_WIDTH), D_MODEL ** -0.5),
        "w_out": nrm(ks[4], (DEPTH, MIX_WIDTH, D_MODEL), MIX_WIDTH ** -0.5),
        "q_norm_a": gain(ks[5], (DEPTH, HEAD_DIM)),
        "k_norm_a": gain(ks[6], (DEPTH, HEAD_DIM)),
        "q_norm_b": gain(ks[7], (DEPTH, HEAD_DIM)),
        "k_norm_b": gain(ks[8], (DEPTH, HEAD_DIM)),
        "lambda_q1": nrm(ks[9], (DEPTH, HEAD_DIM), 0.1),
        "lambda_k1": nrm(ks[10], (DEPTH, HEAD_DIM), 0.1),
        "lambda_q2": nrm(ks[11], (DEPTH, HEAD_DIM), 0.1),
        "lambda_k2": nrm(ks[12], (DEPTH, HEAD_DIM), 0.1),
        "subln_g": gain(ks[13], (DEPTH, 2 * HEAD_DIM)),
        "rel_bias": nrm(ks[14], (N_BUCKETS, N_REL_HEADS), 0.5),
        "w_gate_dense": nrm(ks[15], (N_DENSE, D_MODEL, D_FF), D_MODEL ** -0.5),
        "w_up_dense": nrm(ks[16], (N_DENSE, D_MODEL, D_FF), D_MODEL ** -0.5),
        "w_down_dense": nrm(ks[17], (N_DENSE, D_FF, D_MODEL), D_FF ** -0.5),
        "w_router": nrm(ks[18], (N_MOE, D_MODEL, N_EXPERTS), D_MODEL ** -0.5),
        "w_gate_moe": nrm(ks[19], (N_MOE, N_EXPERTS, D_MODEL, D_FF_EXPERT), D_MODEL ** -0.5),
        "w_up_moe": nrm(ks[20], (N_MOE, N_EXPERTS, D_MODEL, D_FF_EXPERT), D_MODEL ** -0.5),
        "w_down_moe": nrm(ks[21], (N_MOE, N_EXPERTS, D_FF_EXPERT, D_MODEL), D_FF_EXPERT ** -0.5),
    }


def reference(x, norm_mix_g, norm_ffn_g, w_in, w_out, q_norm_a, k_norm_a, q_norm_b, k_norm_b,
              lambda_q1, lambda_k1, lambda_q2, lambda_k2, subln_g, rel_bias,
              w_gate_dense, w_up_dense, w_down_dense, w_router, w_gate_moe, w_up_moe, w_down_moe):
    for layer in range(DEPTH):
        h = rms_norm(x, norm_mix_g[layer])
        x = x + hybrid_mixer(h, w_in[layer], w_out[layer], q_norm_a[layer], k_norm_a[layer],
                             q_norm_b[layer], k_norm_b[layer], lambda_q1[layer], lambda_k1[layer],
                             lambda_q2[layer], lambda_k2[layer], subln_g[layer], rel_bias, layer)
        h = rms_norm(x, norm_ffn_g[layer])
        if layer % 2 == 0:
            i = layer // 2
            x = x + swiglu(h, w_gate_dense[i], w_up_dense[i], w_down_dense[i])
        else:
            i = layer // 2
            x = x + moe_swiglu(h, w_router[i], w_gate_moe[i], w_up_moe[i], w_down_moe[i])
    return x
```

```cpp
#include <hip/hip_runtime.h>
#include <cstdio>
#include <cstdint>

#define GAS __attribute__((address_space(1)))
#define LAS __attribute__((address_space(3)))
typedef unsigned short bf16;
typedef short bf16x8 __attribute__((ext_vector_type(8)));
typedef short s16x4 __attribute__((ext_vector_type(4)));
typedef float f32x4 __attribute__((ext_vector_type(4)));
typedef float f32x2 __attribute__((ext_vector_type(2)));
typedef float f32x16 __attribute__((ext_vector_type(16)));
typedef unsigned u32x4 __attribute__((ext_vector_type(4)));
typedef unsigned u32x2 __attribute__((ext_vector_type(2)));
typedef GAS unsigned gu32;
typedef int v4i __attribute__((ext_vector_type(4)));
typedef int v8i __attribute__((ext_vector_type(8)));

constexpr int NB = 16, SEQ = 2048, NT = NB * SEQ, D = 1024;
constexpr int PROJ = 3072, DFF = 2816, DFFE = 3584, NEXP = 8;
constexpr int NGRP = 48;
constexpr float EPS = 1e-6f;
constexpr float LOG2E = 1.4426950408889634f;
constexpr float C2 = 0.125f * LOG2E;
constexpr int MAXTILES = 264;
constexpr int RT = MAXTILES;
constexpr int NROUNDS = 1;

constexpr size_t MiB = 1u << 20;
constexpr size_t WS_CTL = 0, CTL_ZERO_BYTES = 64 * 1024;
constexpr size_t WS_LUT = 1 * MiB;
constexpr size_t WS_SCAL = WS_LUT + 64 * 1024;
constexpr size_t WS_HIST = WS_SCAL + 4096;
constexpr size_t WS_META = WS_HIST + 16384;
constexpr size_t WS_TOKE = 2 * MiB;
constexpr size_t WS_TOKG = WS_TOKE + 256 * 1024;
constexpr size_t WS_PSLOT = WS_TOKG + 256 * 1024;
constexpr size_t WS_ROWTOK = WS_PSLOT + 256 * 1024;
constexpr size_t WS_WIN = 4 * MiB;
constexpr size_t WS_WOUT = 16 * MiB;
constexpr size_t WS_WGUD = 20 * MiB;
constexpr size_t WS_WDND = 31 * MiB;
constexpr size_t WS_XN = 40 * MiB;
constexpr size_t WS_QKV = 104 * MiB;
constexpr size_t WS_PARTA = 296 * MiB;
constexpr size_t WS_PARTB = 392 * MiB;
constexpr size_t WS_LA = 456 * MiB;
constexpr size_t WS_LB = 459 * MiB;
constexpr size_t WS_RSS = 37 * MiB;
constexpr size_t WS_XR2 = 104 * MiB;
constexpr size_t WS_XB = 392 * MiB;
constexpr size_t WS_HID = 168 * MiB;
constexpr size_t WS_XN8 = 4 * MiB;
constexpr size_t WS_WGUM = 36 * MiB;
constexpr size_t WS_WDNM = 92 * MiB;
constexpr size_t WS_HIDM = 120 * MiB;
constexpr size_t WS_YPAD = 352 * MiB;
constexpr size_t WS_END = 484 * MiB;
constexpr int CW_BAR = 1024;

constexpr int RING_BYTES = 131072;
constexpr int LDSCTL_OFF = RING_BYTES, MISC_OFF = LDSCTL_OFF + 320;
constexpr int LDS_BYTES = 147456;
constexpr int NWAVES = 8;

__device__ __forceinline__ unsigned f2bf(float f) { unsigned u = __builtin_bit_cast(unsigned, f); return (u + 0x7fffu + ((u >> 16) & 1u)) >> 16; }
__device__ __forceinline__ unsigned pk2(float lo, float hi) { return f2bf(lo) | (f2bf(hi) << 16); }
__device__ __forceinline__ float bf2f(unsigned short h) { return __builtin_bit_cast(float, (unsigned)h << 16); }
__device__ __forceinline__ float bflo(unsigned w) { return __builtin_bit_cast(float, w << 16); }
__device__ __forceinline__ float bfhi(unsigned w) { return __builtin_bit_cast(float, w & 0xffff0000u); }
typedef __bf16 bf16x2_t __attribute__((ext_vector_type(2)));
__device__ __forceinline__ unsigned cvt_pk_bf16(float lo, float hi) { const f32x2 v = {lo, hi}; return __builtin_bit_cast(unsigned, __builtin_convertvector(v, bf16x2_t)); }
__device__ __forceinline__ float wave_sum(float v) {
#pragma unroll
    for (int o = 1; o < 64; o <<= 1) v += __shfl_xor(v, o);
    return v;
}
__device__ __forceinline__ unsigned char* opq_p(unsigned char* p) { int z = 0; asm volatile("" : "+v"(z)); return p + (unsigned)__builtin_amdgcn_readfirstlane(z); }
__device__ __forceinline__ int opq(int v) { asm volatile("" : "+v"(v)); return v; }
#define LDS_WAIT() asm volatile("s_waitcnt lgkmcnt(0)" ::: "memory")
#define VM_WAIT() asm volatile("s_waitcnt vmcnt(0)" ::: "memory")

__device__ __forceinline__ int t5_bucket(int n) {
    if (n < 16) return n;
    return 16 + (n >= 19) + (n >= 21) + (n >= 24) + (n >= 27) + (n >= 31) + (n >= 35) + (n >= 40) + (n >= 46) + (n >= 52) + (n >= 59) + (n >= 67) + (n >= 77) + (n >= 87) + (n >= 99) + (n >= 113);
}

namespace pg8 {
constexpr int BM = 256, BK = 64, HALF = 128, HTB = HALF * BK * 2, STAGE_BYTES = 8 * HTB, NXCD = 8, WGM = 8;
__host__ __device__ __forceinline__ int lds_byte(int r, int c) { const int st = (r >> 4) * 2 + (c >> 5), rr = r & 15, cc = c & 31, ob = rr * 64 + cc * 2; return st * 1024 + (ob ^ (((ob >> 9) & 1) << 5)); }
__host__ __device__ __forceinline__ void stage_rc(int b, int& R, int& C) { const int st = b / 1024, sb = b % 1024, swz = sb ^ (((sb >> 9) & 1) << 5); R = (st >> 1) * 16 + swz / 64; C = (st & 1) * 32 + (swz % 64) / 2; }
__host__ __device__ __forceinline__ int perm32(int rho) { const int n = rho >> 4, i = rho & 15; return 8 * (i >> 2) + 4 * n + (i & 3); }

struct Unit { int pm, pn, pb, pa; };
struct Gemm { const bf16* A; const bf16* Bt; int K; const int* rowmap; };

struct StaticOrder {
    int nM, nN, nwg, G, c;
    __device__ void init(int M, int N, int G_, int c_) { nM = M / BM; nN = N / BM; nwg = nM * nN; G = G_; c = c_; }
    __device__ bool next(int i, Unit& u) const {
        const long L = (long)i * G + c; if (L >= nwg) return false;
        int wgid = (int)L; { const int q = nwg / NXCD, r = nwg % NXCD, xcd = wgid % NXCD, off = wgid / NXCD; wgid = (xcd < r ? xcd * (q + 1) : r * (q + 1) + (xcd - r) * q) + off; }
        const int nig = WGM * nN, gid = wgid / nig, fm = gid * WGM, gsz = (nM - fm) < WGM ? (nM - fm) : WGM;
        u.pm = fm + ((wgid % nig) % gsz); u.pn = (wgid % nig) / gsz; u.pb = u.pn; u.pa = u.pm; return true;
    }
};
struct MoeOrder {
    StaticOrder so; int pm0; int te[8];
    __device__ bool next(int i, Unit& u) const {
        if (!so.next(i, u)) return false;
        u.pa = u.pm; u.pm += pm0;
        int e = 0;
#pragma unroll
        for (int k = 0; k < 7; ++k) e += (u.pm >= te[k]) ? 1 : 0;
        u.pb = e * so.nN + u.pn; return true;
    }
};

__device__ __forceinline__ float row_rnorm(const float* rss, int row) {
    if (!rss) return 1.f;
    const f32x4* p = (const f32x4*)(rss + (size_t)row * 16); const f32x4 a = p[0], b = p[1], c = p[2], d = p[3];
    const float t = ((a[0] + a[1]) + (a[2] + a[3])) + ((b[0] + b[1]) + (b[2] + b[3])) + (((c[0] + c[1]) + (c[2] + c[3])) + ((d[0] + d[1]) + (d[2] + d[3])));
    return __builtin_amdgcn_rsqf(t * (1.f / D) + EPS);
}
__device__ __forceinline__ void rn_load(f32x4 (&r)[4], const float* rss, int row) {
    if (!rss) return;
    const f32x4* p = (const f32x4*)(rss + (size_t)row * 16); r[0] = p[0]; r[1] = p[1]; r[2] = p[2]; r[3] = p[3];
}
__device__ __forceinline__ float rn_finish(const f32x4 (&r)[4], const float* rss) {
    if (!rss) return 1.f;
    const f32x4 a = r[0], b = r[1], c = r[2], d = r[3];
    const float t = ((a[0] + a[1]) + (a[2] + a[3])) + ((b[0] + b[1]) + (b[2] + b[3])) + (((c[0] + c[1]) + (c[2] + c[3])) + ((d[0] + d[1]) + (d[2] + d[3])));
    return __builtin_amdgcn_rsqf(t * (1.f / D) + EPS);
}
__device__ __forceinline__ void rn_all(float (&rrv)[8], const float* rss, int row0, int fq) {
    if (!rss) {
#pragma unroll
        for (int g = 0; g < 8; ++g) rrv[g] = 1.f;
        return; }
    f32x4 q[8];
#pragma unroll
    for (int g = 0; g < 8; ++g) q[g] = *(const f32x4*)(rss + (size_t)(row0 + (g >> 2) * HALF + (g & 3) * 16) * 16 + 4 * fq);
    float t8[8];
#pragma unroll
    for (int g = 0; g < 8; ++g) rrv[g] = (q[g][0] + q[g][1]) + (q[g][2] + q[g][3]);
#pragma unroll
    for (int g = 0; g < 8; ++g) t8[g] = __shfl_xor(rrv[g], 16);
#pragma unroll
    for (int g = 0; g < 8; ++g) rrv[g] += t8[g];
#pragma unroll
    for (int g = 0; g < 8; ++g) t8[g] = __shfl_xor(rrv[g], 32);
#pragma unroll
    for (int g = 0; g < 8; ++g) rrv[g] = __builtin_amdgcn_rsqf((rrv[g] + t8[g]) * (1.f / D) + EPS);
}
struct EpiQKV {
    bf16* QKV; const float* gn[4]; const float* rss;
    __device__ __forceinline__ void operator()(const f32x4 (&acc)[2][2][4][2], const Unit& u, int wr, int wc, int fr, int fq) const {
        const int G = u.pn * 4 + wc, kind = G >> 3;
        const float* gp = kind == 0 ? gn[0] : kind == 1 ? gn[1] : kind == 3 ? gn[2] : kind == 4 ? gn[3] : nullptr;
        const float qs = (kind == 0 || kind == 3) ? C2 : 1.f;
        f32x4 gv[2][2];
#pragma unroll
        for (int bj = 0; bj < 2; ++bj)
#pragma unroll
            for (int n = 0; n < 2; ++n) gv[bj][n] = gp ? *(const f32x4*)(gp + 32 * bj + 8 * fq + 4 * n) * qs : (f32x4){1.f, 1.f, 1.f, 1.f};
        bf16* base = QKV + (size_t)G * NT * 64 + 8 * fq;
        float rrv[8]; rn_all(rrv, rss, u.pm * BM + wr * 64 + fr, fq);
        float ssv[8];
#pragma unroll
        for (int g8 = 0; g8 < 8; ++g8) { float ss = 0.f;
#pragma unroll
            for (int bj = 0; bj < 2; ++bj)
#pragma unroll
                for (int n = 0; n < 2; ++n) { const f32x4 v = acc[g8 >> 2][bj][g8 & 3][n]; ss += (v[0] * v[0] + v[1] * v[1]) + (v[2] * v[2] + v[3] * v[3]); }
            ssv[g8] = ss; }
        if (gp) {
            float t8[8];
#pragma unroll
            for (int g8 = 0; g8 < 8; ++g8) t8[g8] = __shfl_xor(ssv[g8], 16);
#pragma unroll
            for (int g8 = 0; g8 < 8; ++g8) ssv[g8] += t8[g8];
#pragma unroll
            for (int g8 = 0; g8 < 8; ++g8) t8[g8] = __shfl_xor(ssv[g8], 32);
#pragma unroll
            for (int g8 = 0; g8 < 8; ++g8) ssv[g8] += t8[g8];
        }
#pragma unroll
        for (int ai = 0; ai < 2; ++ai)
#pragma unroll
            for (int m = 0; m < 4; ++m) {
                const int row = u.pm * BM + ai * HALF + wr * 64 + m * 16 + fr;
                const float rr = rrv[ai * 4 + m];
                const float ss = ssv[ai * 4 + m];
                const float r = (gp ? __builtin_amdgcn_rsqf(ss * (rr * rr) * (1.f / 64.f) + EPS) : 1.f) * rr;
#pragma unroll
                for (int bj = 0; bj < 2; ++bj) {
                    const f32x4 v0 = acc[ai][bj][m][0] * gv[bj][0] * r, v1 = acc[ai][bj][m][1] * gv[bj][1] * r;
                    u32x4 w; w.x = cvt_pk_bf16(v0[0], v0[1]); w.y = cvt_pk_bf16(v0[2], v0[3]); w.z = cvt_pk_bf16(v1[0], v1[1]); w.w = cvt_pk_bf16(v1[2], v1[3]);
                    *(u32x4*)(base + (size_t)row * 64 + 32 * bj) = w;
                }
            }
    }
};
struct EpiRes {
    const float* res; float* out;
    __device__ __forceinline__ void operator()(const f32x4 (&acc)[2][2][4][2], const Unit& u, int wr, int wc, int fr, int fq) const {
        const int col0 = u.pn * BM + wc * 32 + 8 * fq;
#pragma unroll
        for (int ai = 0; ai < 2; ++ai)
#pragma unroll
            for (int m = 0; m < 4; ++m) {
                const size_t ro = (size_t)(u.pm * BM + ai * HALF + wr * 64 + m * 16 + fr) * D + col0;
#pragma unroll
                for (int bj = 0; bj < 2; ++bj) {
                    const f32x4 r0 = *(const f32x4*)(res + ro + bj * HALF), r1 = *(const f32x4*)(res + ro + bj * HALF + 4);
                    *(f32x4*)(out + ro + bj * HALF) = r0 + acc[ai][bj][m][0];
                    *(f32x4*)(out + ro + bj * HALF + 4) = r1 + acc[ai][bj][m][1];
                }
            }
    }
};
struct EpiResN {
    const float* res32; const bf16* res16; float* out32; bf16* out16; float* rss; int ld16;
    __device__ __forceinline__ void operator()(const f32x4 (&acc)[2][2][4][2], const Unit& u, int wr, int wc, int fr, int fq) const {
        const int col0 = u.pn * BM + wc * 32 + 8 * fq;
#pragma unroll
        for (int ai = 0; ai < 2; ++ai) {
            u32x4 rwv[4][2];
            if (!res32) {
#pragma unroll
                for (int m = 0; m < 4; ++m)
#pragma unroll
                    for (int bj = 0; bj < 2; ++bj) rwv[m][bj] = *(const u32x4*)(res16 + (size_t)(u.pm * BM + ai * HALF + wr * 64 + m * 16 + fr) * D + col0 + bj * HALF);
            }
            float ssv[4];
#pragma unroll
            for (int m = 0; m < 4; ++m) {
                const int row = u.pm * BM + ai * HALF + wr * 64 + m * 16 + fr;
                const size_t ro = (size_t)row * D + col0; float ss = 0.f;
#pragma unroll
                for (int bj = 0; bj < 2; ++bj) {
                    f32x4 r0, r1;
                    if (res32) { r0 = *(const f32x4*)(res32 + ro + bj * HALF); r1 = *(const f32x4*)(res32 + ro + bj * HALF + 4); }
                    else { const u32x4 rw = rwv[m][bj]; r0 = (f32x4){bflo(rw.x), bfhi(rw.x), bflo(rw.y), bfhi(rw.y)}; r1 = (f32x4){bflo(rw.z), bfhi(rw.z), bflo(rw.w), bfhi(rw.w)}; }
                    const f32x4 v0 = r0 + acc[ai][bj][m][0], v1 = r1 + acc[ai][bj][m][1];
                    if (out32) { *(f32x4*)(out32 + ro + bj * HALF) = v0; *(f32x4*)(out32 + ro + bj * HALF + 4) = v1; }
                    if (out16) { u32x4 w; w.x = cvt_pk_bf16(v0[0], v0[1]); w.y = cvt_pk_bf16(v0[2], v0[3]); w.z = cvt_pk_bf16(v1[0], v1[1]); w.w = cvt_pk_bf16(v1[2], v1[3]);
                        *(u32x4*)(out16 + (size_t)row * ld16 + col0 + bj * HALF) = w;
                        ss += ((v0[0] * v0[0] + v0[1] * v0[1]) + (v0[2] * v0[2] + v0[3] * v0[3])) + ((v1[0] * v1[0] + v1[1] * v1[1]) + (v1[2] * v1[2] + v1[3] * v1[3])); }
                }
                ssv[m] = ss;
                __builtin_amdgcn_sched_barrier(0);
            }
            if (out16 && rss) { float t4[4];
#pragma unroll
                for (int m = 0; m < 4; ++m) t4[m] = __shfl_xor(ssv[m], 16);
#pragma unroll
                for (int m = 0; m < 4; ++m) ssv[m] += t4[m];
#pragma unroll
                for (int m = 0; m < 4; ++m) t4[m] = __shfl_xor(ssv[m], 32);
#pragma unroll
                for (int m = 0; m < 4; ++m) { ssv[m] += t4[m]; if (fq == 0) rss[(size_t)(u.pm * BM + ai * HALF + wr * 64 + m * 16 + fr) * 16 + u.pn * 4 + wc] = ssv[m]; }
            }
        }
    }
};
__device__ __forceinline__ float silu_mul(float g, float u) { return g * __builtin_amdgcn_rcpf(1.f + __builtin_amdgcn_exp2f(-g * LOG2E)) * u; }
__device__ __forceinline__ f32x4 silu_mul4(f32x4 g, f32x4 u) {
    const f32x4 t = g * (-LOG2E); f32x4 e; e[0] = __builtin_amdgcn_exp2f(t[0]); e[1] = __builtin_amdgcn_exp2f(t[1]); e[2] = __builtin_amdgcn_exp2f(t[2]); e[3] = __builtin_amdgcn_exp2f(t[3]);
    const f32x4 d = e + 1.f; f32x4 r; r[0] = __builtin_amdgcn_rcpf(d[0]); r[1] = __builtin_amdgcn_rcpf(d[1]); r[2] = __builtin_amdgcn_rcpf(d[2]); r[3] = __builtin_amdgcn_rcpf(d[3]);
    return (g * u) * r; }
struct EpiSwiGLU {
    bf16* H; int ldc; int pm0; const float* rss;
    __device__ __forceinline__ void operator()(const f32x4 (&acc)[2][2][4][2], const Unit& u, int wr, int wc, int fr, int fq) const {
        const int col0 = u.pn * HALF + wc * 32 + 8 * fq;
        float rrv[8]; rn_all(rrv, rss, (u.pm - pm0) * BM + wr * 64 + fr, fq);
#pragma unroll
        for (int ai = 0; ai < 2; ++ai)
#pragma unroll
            for (int m = 0; m < 4; ++m) {
                const int row = (u.pm - pm0) * BM + ai * HALF + wr * 64 + m * 16 + fr;
                const float rr = rrv[ai * 4 + m];
                const f32x4 g0 = acc[ai][0][m][0] * rr, g1 = acc[ai][0][m][1] * rr, u0 = acc[ai][1][m][0] * rr, u1 = acc[ai][1][m][1] * rr;
                u32x4 w;
                const f32x4 h0 = silu_mul4(g0, u0), h1 = silu_mul4(g1, u1);
                w.x = cvt_pk_bf16(h0[0], h0[1]); w.y = cvt_pk_bf16(h0[2], h0[3]); w.z = cvt_pk_bf16(h1[0], h1[1]); w.w = cvt_pk_bf16(h1[2], h1[3]);
                *(u32x4*)(H + (size_t)row * ldc + col0) = w;
            }
    }
};
struct EpiBf {
    bf16* O;
    __device__ __forceinline__ void operator()(const f32x4 (&acc)[2][2][4][2], const Unit& u, int wr, int wc, int fr, int fq) const {
        const int col0 = u.pn * BM + wc * 32 + 8 * fq;
#pragma unroll
        for (int ai = 0; ai < 2; ++ai)
#pragma unroll
            for (int m = 0; m < 4; ++m) {
                bf16* rowp = O + (size_t)(u.pm * BM + ai * HALF + wr * 64 + m * 16 + fr) * D + col0;
#pragma unroll
                for (int bj = 0; bj < 2; ++bj) { const f32x4 v0 = acc[ai][bj][m][0], v1 = acc[ai][bj][m][1];
                    u32x4 w; w.x = cvt_pk_bf16(v0[0], v0[1]); w.y = cvt_pk_bf16(v0[2], v0[3]); w.z = cvt_pk_bf16(v1[0], v1[1]); w.w = cvt_pk_bf16(v1[2], v1[3]);
                    *(u32x4*)(rowp + bj * HALF) = w; }
            }
    }
};

__device__ __forceinline__ float clamp448(float v) { return __builtin_amdgcn_fmed3f(v, -448.f, 448.f); }
__device__ __forceinline__ unsigned pk4_fp8(float a, float b, float c, float d) {
    int w = 0; w = __builtin_amdgcn_cvt_pk_fp8_f32(clamp448(a), clamp448(b), w, false); w = __builtin_amdgcn_cvt_pk_fp8_f32(clamp448(c), clamp448(d), w, true); return (unsigned)w; }
struct EpiSwiGLU8 {
    unsigned char* H; int ldc; float sg, su;
    __device__ __forceinline__ void operator()(const f32x4 (&acc)[2][2][4][2], const Unit& u, int wr, int wc, int fr, int fq) const {
        const int col0 = u.pn * HALF + wc * 32 + 8 * fq; const float su8 = su * 8.f;
#pragma unroll
        for (int ai = 0; ai < 2; ++ai)
#pragma unroll
            for (int m = 0; m < 4; ++m) {
                const int row = u.pm * BM + ai * HALF + wr * 64 + m * 16 + fr;
                const f32x4 g0 = acc[ai][0][m][0] * sg, g1 = acc[ai][0][m][1] * sg, u0 = acc[ai][1][m][0] * su8, u1 = acc[ai][1][m][1] * su8;
                u32x2 w;
                const f32x4 h0 = silu_mul4(g0, u0), h1 = silu_mul4(g1, u1);
                w.x = pk4_fp8(h0[0], h0[1], h0[2], h0[3]); w.y = pk4_fp8(h1[0], h1[1], h1[2], h1[3]);
                *(u32x2*)(H + (size_t)row * ldc + col0) = w;
                __builtin_amdgcn_sched_barrier(0);
            }
    }
};
struct EpiBfS {
    bf16* O; float s;
    __device__ __forceinline__ void operator()(const f32x4 (&acc)[2][2][4][2], const Unit& u, int wr, int wc, int fr, int fq) const {
        const int col0 = u.pn * BM + wc * 32 + 8 * fq;
#pragma unroll
        for (int ai = 0; ai < 2; ++ai)
#pragma unroll
            for (int m = 0; m < 4; ++m) {
                bf16* rowp = O + (size_t)(u.pm * BM + ai * HALF + wr * 64 + m * 16 + fr) * D + col0;
#pragma unroll
                for (int bj = 0; bj < 2; ++bj) { const f32x4 v0 = acc[ai][bj][m][0] * s, v1 = acc[ai][bj][m][1] * s;
                    u32x4 w; w.x = cvt_pk_bf16(v0[0], v0[1]); w.y = cvt_pk_bf16(v0[2], v0[3]); w.z = cvt_pk_bf16(v1[0], v1[1]); w.w = cvt_pk_bf16(v1[2], v1[3]);
                    *(u32x4*)(rowp + bj * HALF) = w; }
            }
    }
};

template <class Epi, class Sched, bool GATHER, bool FP8 = false>
__device__ __forceinline__ void gemm_phase(LAS unsigned char* lds, const Gemm g, const Sched& S, const Epi& E) {
    const int tid = opq(threadIdx.x), wid = __builtin_amdgcn_readfirstlane(tid >> 6), lane = tid & 63, wr = wid >> 2, wc = wid & 3, fr = lane & 15, fq = lane >> 4;
    const int K = g.K; int nt = K / BK; asm volatile("" : "+s"(nt));
    unsigned voffB[2], colA[2]; int RA[2];
#pragma unroll
    for (int i = 0; i < 2; ++i) { int R, C; stage_rc(tid * 16 + i * 8192, R, C); const int Rb = (R & ~31) + perm32(R & 31);
        RA[i] = R; colA[i] = (unsigned)C * 2u; voffB[i] = (unsigned)(Rb * K + C) * 2u; }
    const size_t kstep = (size_t)(BK * 2);
    const size_t hstep = (size_t)HALF * K * 2;
    const size_t tstep = 2 * hstep;
    const unsigned ldsw = (unsigned)wid * 1024u;
    const int aoff = lds_byte(wr * 64 + fr, fq * 8), boff = lds_byte(wc * 32 + fr, fq * 8);
#define PG8_SA(b, h) (((b) * 2 + (h)) * HTB)
#define PG8_SB(b, h) ((4 + (b) * 2 + (h)) * HTB)
#define PG8_STAGE(bufoff, gbase, voff) do { _Pragma("unroll") for (int _i = 0; _i < 2; ++_i) \
        __builtin_amdgcn_global_load_lds((const unsigned*)((const char*)(gbase) + (voff)[_i]), (LAS unsigned*)(lds + (bufoff) + ldsw + _i * 8192), 16, 0, 0); } while (0)
#define PG8_LDA(dst, b, h) do { _Pragma("unroll") for (int m = 0; m < 4; ++m) _Pragma("unroll") for (int k = 0; k < 2; ++k) dst[m][k] = *(const LAS bf16x8*)(lds + PG8_SA(b, h) + aoff + m * 2048 + k * 1024); } while (0)
#define PG8_LDB(dst, b, h) do { _Pragma("unroll") for (int n = 0; n < 2; ++n) _Pragma("unroll") for (int k = 0; k < 2; ++k) dst[n][k] = *(const LAS bf16x8*)(lds + PG8_SB(b, h) + boff + n * 2048 + k * 1024); } while (0)
#define PG8_MMA(ai, bj, At, Bt) do { __builtin_amdgcn_s_setprio(1); _Pragma("unroll") for (int m = 0; m < 4; ++m) _Pragma("unroll") for (int n = 0; n < 2; ++n) { \
        if constexpr (FP8) { const v4i b0_ = __builtin_bit_cast(v4i, Bt[n][0]), b1_ = __builtin_bit_cast(v4i, Bt[n][1]), a0_ = __builtin_bit_cast(v4i, At[m][0]), a1_ = __builtin_bit_cast(v4i, At[m][1]); \
            const v8i bb_ = __builtin_shufflevector(b0_, b1_, 0, 1, 2, 3, 4, 5, 6, 7), aa_ = __builtin_shufflevector(a0_, a1_, 0, 1, 2, 3, 4, 5, 6, 7); \
            asm volatile("v_mfma_f32_16x16x128_f8f6f4 %0, %1, %2, %0" : "+v"(acc[ai][bj][m][n]) : "v"(bb_), "v"(aa_)); } \
        else { _Pragma("unroll") for (int k = 0; k < 2; ++k) acc[ai][bj][m][n] = __builtin_amdgcn_mfma_f32_16x16x32_bf16(Bt[n][k], At[m][k], acc[ai][bj][m][n], 0, 0, 0); } } \
        __builtin_amdgcn_s_setprio(0); } while (0)
#define PG8_WAIT_V(n) asm volatile("s_waitcnt vmcnt(" #n ")" ::: "memory")
#define PG8_WAIT_L(n) asm volatile("s_waitcnt lgkmcnt(" #n ")" ::: "memory")
#define PG8_BAR __builtin_amdgcn_s_barrier()
#define PG8_SCHED __builtin_amdgcn_sched_barrier(0)
#define PG8_MKOFF(O, U) do { _Pragma("unroll") for (int _h = 0; _h < 2; ++_h) _Pragma("unroll") for (int _i = 0; _i < 2; ++_i) { \
        if constexpr (GATHER) O[_h][_i] = (unsigned)g.rowmap[(U).pm * BM + _h * HALF + RA[_i]] * (unsigned)(K * 2) + colA[_i]; \
        else O[_h][_i] = (unsigned)((_h * HALF + RA[_i]) * K) * 2u + colA[_i]; } } while (0)
    Unit cur, nxt; int ui = 0;
    if (!S.next(0, cur)) return;
    f32x4 acc[2][2][4][2];
#pragma unroll
    for (int a = 0; a < 2; ++a)
#pragma unroll
        for (int b = 0; b < 2; ++b)
#pragma unroll
            for (int m = 0; m < 4; ++m)
#pragma unroll
                for (int n = 0; n < 2; ++n) acc[a][b][m][n] = (f32x4){0.f, 0.f, 0.f, 0.f};
    bf16x8 At[4][2], B0[2][2], B1[2][2];
    int sc1_ = 0x7f7f7f7f; asm volatile("" : "+v"(sc1_));
    unsigned oc[2][2], on[2][2];
    PG8_MKOFF(oc, cur);
    const char* cA = (const char*)g.A + (GATHER ? (size_t)0 : (size_t)cur.pa * tstep); const char* cB = (const char*)g.Bt + (size_t)cur.pb * tstep;
    PG8_STAGE(PG8_SB(0, 0), cB, voffB); PG8_STAGE(PG8_SB(0, 1), cB + hstep, voffB); PG8_STAGE(PG8_SA(0, 0), cA, oc[0]); PG8_STAGE(PG8_SA(0, 1), cA, oc[1]);
    if (wr == 1) PG8_BAR;
    PG8_WAIT_V(2); PG8_BAR;
    PG8_STAGE(PG8_SB(1, 0), cB + kstep, voffB); PG8_STAGE(PG8_SA(1, 0), cA + kstep, oc[0]); PG8_STAGE(PG8_SB(1, 1), cB + hstep + kstep, voffB);
    PG8_WAIT_V(6); PG8_BAR;
    for (;;) {
        const bool has_next = S.next(ui + 1, nxt);
        if (has_next) {
            if constexpr (GATHER) {
#pragma unroll
                for (int _h = 0; _h < 2; ++_h)
#pragma unroll
                    for (int _i = 0; _i < 2; ++_i) asm volatile("global_load_dword %0, %1, off" : "=&v"(on[_h][_i]) : "v"(g.rowmap + (nxt.pm * BM + _h * HALF + RA[_i])) : "memory");
                if (nt < 4) asm volatile("s_waitcnt vmcnt(0)" ::: "memory");
            } else { PG8_MKOFF(on, nxt); }
        } else {
#pragma unroll
            for (int _h = 0; _h < 2; ++_h)
#pragma unroll
                for (int _i = 0; _i < 2; ++_i) on[_h][_i] = oc[_h][_i]; }
        const char* nA = has_next ? (const char*)g.A + (GATHER ? (size_t)0 : (size_t)nxt.pa * tstep) : cA; const char* nB = has_next ? (const char*)g.Bt + (size_t)nxt.pb * tstep : cB;
        for (int t = 0; t < nt; t += 2) {
            const bool last = (t == nt - 2);
            const char* a1 = cA + (size_t)(t + 1) * kstep;
            const char* a2 = last ? nA : cA + (size_t)(t + 2) * kstep; const char* b2 = last ? nB : cB + (size_t)(t + 2) * kstep;
            const char* a3 = a2 + kstep; const char* b3 = b2 + kstep;
            unsigned o2[2][2];
#pragma unroll
            for (int _h = 0; _h < 2; ++_h)
#pragma unroll
                for (int _i = 0; _i < 2; ++_i) {
                    if constexpr (GATHER) { if (last && has_next) { asm volatile("" : "+v"(on[_h][_i])); on[_h][_i] = on[_h][_i] * (unsigned)(K * 2) + colA[_i]; } }
                    o2[_h][_i] = (GATHER && last) ? on[_h][_i] : oc[_h][_i]; }
            PG8_LDB(B0, 0, 0); PG8_LDB(B1, 0, 1); PG8_SCHED; PG8_LDA(At, 0, 0); PG8_STAGE(PG8_SA(1, 1), a1, oc[1]);
            PG8_WAIT_V(8); PG8_WAIT_L(0); PG8_BAR; PG8_MMA(0, 0, At, B0); PG8_MMA(0, 1, At, B1); PG8_BAR; PG8_SCHED;
            PG8_LDA(At, 0, 1); PG8_STAGE(PG8_SB(0, 0), b2, voffB); PG8_STAGE(PG8_SB(0, 1), b2 + hstep, voffB); PG8_STAGE(PG8_SA(0, 0), a2, o2[0]);
            PG8_WAIT_V(8); PG8_WAIT_L(0); PG8_BAR; PG8_MMA(1, 0, At, B0); PG8_MMA(1, 1, At, B1); PG8_BAR; PG8_SCHED;
            PG8_LDB(B0, 1, 0); PG8_LDB(B1, 1, 1); PG8_SCHED; PG8_LDA(At, 1, 0); PG8_STAGE(PG8_SA(0, 1), a2, o2[1]);
            PG8_WAIT_V(8); PG8_WAIT_L(0); PG8_BAR; PG8_MMA(0, 0, At, B0); PG8_MMA(0, 1, At, B1); PG8_BAR; PG8_SCHED;
            PG8_LDA(At, 1, 1); PG8_STAGE(PG8_SB(1, 0), b3, voffB); PG8_STAGE(PG8_SB(1, 1), b3 + hstep, voffB); PG8_STAGE(PG8_SA(1, 0), a3, o2[0]);
            PG8_WAIT_V(8); PG8_WAIT_L(0); PG8_BAR; PG8_MMA(1, 0, At, B0); PG8_MMA(1, 1, At, B1); PG8_BAR; PG8_SCHED;
        }
        if (wr == 0) PG8_BAR;
        if constexpr (FP8) asm volatile("s_nop 15\n\ts_nop 15\n\ts_nop 15" ::: "memory");
        E(acc, cur, wr, wc, fr, fq);
        if (!has_next) break;
#pragma unroll
        for (int a = 0; a < 2; ++a)
#pragma unroll
            for (int b = 0; b < 2; ++b)
#pragma unroll
                for (int m = 0; m < 4; ++m)
#pragma unroll
                    for (int n = 0; n < 2; ++n) acc[a][b][m][n] = (f32x4){0.f, 0.f, 0.f, 0.f};
        cur = nxt; cA = nA; cB = nB; ++ui;
#pragma unroll
        for (int _h = 0; _h < 2; ++_h)
#pragma unroll
            for (int _i = 0; _i < 2; ++_i) oc[_h][_i] = on[_h][_i];
        if (wr == 1) PG8_BAR;
    }
    PG8_WAIT_V(0);
    PG8_BAR;
#undef PG8_SA
#undef PG8_SB
#undef PG8_STAGE
#undef PG8_LDA
#undef PG8_LDB
#undef PG8_MMA
#undef PG8_WAIT_V
#undef PG8_WAIT_L
#undef PG8_BAR
#undef PG8_SCHED
#undef PG8_MKOFF
}
}

namespace att {
constexpr int KBUF = 0, VBUF = 49152, LUTO = 98304, LUTN = 384;
typedef short v4i16_t __attribute__((ext_vector_type(4)));
__device__ __forceinline__ s16x4 vtr(const LAS char* p) { return __builtin_bit_cast(s16x4, __builtin_amdgcn_ds_read_tr16_b64_v4i16((LAS v4i16_t*)p)); }
__device__ __forceinline__ void glds16(const void* gsrc, unsigned lds_dst) { unsigned keep;
    asm volatile("s_mov_b32 %0, m0\n\ts_mov_b32 m0, %2\n\ts_nop 0\n\tglobal_load_lds_dwordx4 %1, off\n\ts_mov_b32 m0, %0" : "=&s"(keep) : "v"(gsrc), "s"(lds_dst) : "memory"); }

struct Job {
    int b, dil, rho, U0, kt_lo, kt_hi;
    int qG, kG, vG, lutid;
    bf16* O; float* L; int opitch, ooff, lpitch, loff;
    float lam, oml; const float* sg;
};

template <int DV, bool WINDOW>
__device__ __forceinline__ void unit(LAS unsigned char* lds, const bf16* __restrict__ QKV, const float* __restrict__ RLUT, const Job& J) {
    constexpr int NDH = DV / 32;
    const int tid = opq(threadIdx.x), lane = tid & 63, r32 = lane & 31, hi = lane >> 5;
    const int wid = __builtin_amdgcn_readfirstlane(tid >> 6), hsel = wid >> 2, w4 = wid & 3;
    const size_t tb = (size_t)J.b * SEQ;
    const bf16* Qg = QKV + ((size_t)J.qG * NT + tb) * 64;
    const bf16* Kg = QKV + ((size_t)J.kG * NT + tb) * 64;
    const bf16* Vg = QKV + ((size_t)J.vG * NT + tb) * 64;
    const int dil = J.dil, rho = J.rho;
    asm volatile("s_waitcnt lgkmcnt(0)\n\ts_barrier" ::: "memory");
    const unsigned lds0 = (unsigned)(uintptr_t)lds;
#define ATT_LOADS(s_, slot, cbase, ncnt) do { const int k0_ = (J.kt_lo + (s_)) * 64; \
        _Pragma("unroll") for (int pp = 0; pp < (ncnt); ++pp) { const int c_ = (cbase) + pp; \
            glds16(Kg + (size_t)(rho + dil * (k0_ + 8 * c_ + (lane >> 3))) * 64 + ((lane & 7) ^ (lane >> 3)) * 8, (unsigned)__builtin_amdgcn_readfirstlane(lds0 + KBUF + (slot) * 16384 + hsel * 8192 + c_ * 1024)); } \
        _Pragma("unroll") for (int pp = 0; pp < (ncnt); ++pp) { const int p_ = (cbase) + pp, dh_ = p_ >> 2, kg_ = p_ & 3; \
            glds16(Vg + (size_t)(rho + dil * (k0_ + 16 * kg_ + (lane >> 2))) * 64 + dh_ * 32 + (lane & 3) * 8, (unsigned)__builtin_amdgcn_readfirstlane(lds0 + VBUF + (slot) * 16384 + hsel * 8192 + p_ * 1024)); } } while (0)
    const int par = w4 & 1, cb4 = 4 * (w4 >> 1), S = J.kt_hi - J.kt_lo;
    ATT_LOADS(0, 0, 2 * w4, 2);
    if (par == 1) ATT_LOADS(1, 1, cb4, 4);
    const int Q0w = J.U0 + 32 * w4;
    bf16x8 qr[4];
    { const bf16* qrow = Qg + (size_t)(rho + dil * (Q0w + r32)) * 64 + hi * 8;
#pragma unroll
      for (int d0 = 0; d0 < 4; ++d0) qr[d0] = *(const bf16x8*)(qrow + d0 * 16); }
    { LAS float* L = (LAS float*)(lds + LUTO + hsel * (LUTN * 4)); const float* src = RLUT + (size_t)J.lutid * LUTN; const int i = tid & 255;
      L[i] = src[i]; if (i < LUTN - 256) L[256 + i] = src[256 + i]; }
    f32x16 o[NDH];
#pragma unroll
    for (int i = 0; i < NDH; ++i) o[i] = f32x16{};
    float lsum = 0.f;
    const LAS char* kfb = (const LAS char*)(lds + KBUF + hsel * 8192 + r32 * 128);
    int koff[4];
#pragma unroll
    for (int d0 = 0; d0 < 4; ++d0) koff[d0] = (((2 * d0 + hi) ^ (r32 & 7)) << 4);
    const LAS char* vfb = (const LAS char*)(lds + VBUF + (DV == 64 ? hsel * 8192 : 0) + ((lane >> 4) & 1) * 32 + (lane & 3) * 8 + (4 * hi + ((lane & 15) >> 2)) * 64);
    const LAS char* lutb = (const LAS char*)(lds + LUTO + hsel * (LUTN * 4));
    int buf = 0, bufn = 2;
    for (int kt = J.kt_lo; kt < J.kt_hi; ++kt) {
        const int sst = kt - J.kt_lo;
        if (sst == 0 || (sst & 1) == par) asm volatile("s_waitcnt vmcnt(0) lgkmcnt(0)\n\ts_barrier" ::: "memory"); else asm volatile("s_waitcnt lgkmcnt(0)\n\ts_barrier" ::: "memory");
        if ((sst & 1) == par && sst + 2 < S) ATT_LOADS(sst + 2, bufn, cb4, 4);
        const int k0 = kt * 64, dq = Q0w - k0;
        const bool need = WINDOW ? (dq >= -31 && dq <= 191) : true;
        if (need) {
            f32x16 c0, c1;
            if (!WINDOW && dq >= 191) {
                const float cf = *(const LAS float*)(lutb + (383 - 256) * 4);
#pragma unroll
                for (int r = 0; r < 16; ++r) { c0[r] = cf; c1[r] = cf; }
            } else {
                unsigned lpo_ = (unsigned)(uintptr_t)(lutb + (255 - dq - r32 + 4 * hi) * 4); asm volatile("" : "+v"(lpo_));
                const LAS char* lp = (const LAS char*)(uintptr_t)lpo_;
#pragma unroll
                for (int r = 0; r < 16; ++r) { const int off = ((r & 3) + 8 * (r >> 2)) * 4; c0[r] = *(const LAS float*)(lp + off); c1[r] = *(const LAS float*)(lp + off + 128); }
            }
            const LAS char* kp = kfb + buf * 16384;
            const LAS char* vp = vfb + buf * 16384;
            bf16x8 kf[8];
#pragma unroll
            for (int d0 = 0; d0 < 4; ++d0) { kf[2 * d0] = *(const LAS bf16x8*)(kp + koff[d0]); kf[2 * d0 + 1] = *(const LAS bf16x8*)(kp + koff[d0] + 4096); }
            __builtin_amdgcn_sched_barrier(0);
#pragma unroll
            for (int d0 = 0; d0 < 4; ++d0) {
                c0 = __builtin_amdgcn_mfma_f32_32x32x16_bf16(kf[2 * d0], qr[d0], c0, 0, 0, 0);
                c1 = __builtin_amdgcn_mfma_f32_32x32x16_bf16(kf[2 * d0 + 1], qr[d0], c1, 0, 0, 0);
            }
            s16x4 vl[8], vh[8];
#define ATT_VREAD(b) do { _Pragma("unroll") for (int i_ = 0; i_ < 8; ++i_) { vl[i_] = vtr(vp + ((b) * 2 + (i_ >> 2)) * 4096 + (i_ & 3) * 1024); vh[i_] = vtr(vp + ((b) * 2 + (i_ >> 2)) * 4096 + (i_ & 3) * 1024 + 512); } } while (0)
#define ATT_PV(b) do { _Pragma("unroll") for (int i_ = 0; i_ < 8; ++i_) { const bf16x8 vf_ = (bf16x8){vl[i_][0], vl[i_][1], vl[i_][2], vl[i_][3], vh[i_][0], vh[i_][1], vh[i_][2], vh[i_][3]}; \
                o[(b) * 2 + (i_ >> 2)] = __builtin_amdgcn_mfma_f32_32x32x16_bf16(vf_, __builtin_bit_cast(bf16x8, pw[i_ & 3]), o[(b) * 2 + (i_ >> 2)], 0, 0, 0); } } while (0)
            ATT_VREAD(0);
            float s0 = 0.f, s1 = 0.f;
#pragma unroll
            for (int r = 0; r < 16; ++r) { c0[r] = __builtin_amdgcn_exp2f(c0[r]); c1[r] = __builtin_amdgcn_exp2f(c1[r]); s0 += c0[r]; s1 += c1[r]; }
            lsum += s0 + s1;
            u32x4 pw[4];
#pragma unroll
            for (int s = 0; s < 2; ++s) {
                pw[s] = (u32x4){cvt_pk_bf16(c0[8 * s], c0[8 * s + 1]), cvt_pk_bf16(c0[8 * s + 2], c0[8 * s + 3]), cvt_pk_bf16(c0[8 * s + 4], c0[8 * s + 5]), cvt_pk_bf16(c0[8 * s + 6], c0[8 * s + 7])};
                pw[2 + s] = (u32x4){cvt_pk_bf16(c1[8 * s], c1[8 * s + 1]), cvt_pk_bf16(c1[8 * s + 2], c1[8 * s + 3]), cvt_pk_bf16(c1[8 * s + 4], c1[8 * s + 5]), cvt_pk_bf16(c1[8 * s + 6], c1[8 * s + 7])};
            }
            ATT_PV(0);
            if constexpr (NDH == 4) { ATT_VREAD(1); ATT_PV(1); }
#undef ATT_VREAD
#undef ATT_PV
        }
        bufn = buf; buf = (buf == 2) ? 0 : buf + 1;
    }
#undef ATT_LOADS
    { auto rr = __builtin_amdgcn_permlane32_swap(__float_as_uint(lsum), __float_as_uint(lsum), false, false); lsum = __uint_as_float(rr[0]) + __uint_as_float(rr[1]); }
    const size_t tok = tb + (size_t)(rho + dil * (Q0w + r32));
    if constexpr (DV == 128) {
        LAS float* X = (LAS float*)lds;
        __syncthreads();
        if (hsel == 1) { const float sc = J.lam / lsum;
#pragma unroll
            for (int dh = 0; dh < 4; ++dh)
#pragma unroll
                for (int r = 0; r < 16; ++r) X[((w4 * 4 + dh) * 16 + r) * 64 + lane] = o[dh][r] * sc; }
        __syncthreads();
        if (hsel == 0) { const float r1 = 1.f / lsum; float ss = 0.f;
            f32x4 gq[4][4];
#pragma unroll
            for (int dh = 0; dh < 4; ++dh)
#pragma unroll
                for (int g4 = 0; g4 < 4; ++g4) gq[dh][g4] = *(const f32x4*)(J.sg + 32 * dh + 8 * g4 + 4 * hi);
#pragma unroll
            for (int dh = 0; dh < 4; ++dh)
#pragma unroll
                for (int r = 0; r < 16; ++r) { const float a = o[dh][r] * r1 - X[((w4 * 4 + dh) * 16 + r) * 64 + lane]; o[dh][r] = a; ss += a * a; }
            { auto rr = __builtin_amdgcn_permlane32_swap(__float_as_uint(ss), __float_as_uint(ss), false, false); ss = __uint_as_float(rr[0]) + __uint_as_float(rr[1]); }
            const float rn = J.oml / sqrtf(ss * (1.f / 128.f) + EPS);
            bf16* orow = J.O + tok * J.opitch + J.ooff + 4 * hi;
#pragma unroll
            for (int dh = 0; dh < 4; ++dh)
#pragma unroll
                for (int g4 = 0; g4 < 4; ++g4) { const f32x4 g = gq[dh][g4];
                    u32x2 w; w.x = cvt_pk_bf16(o[dh][4 * g4] * rn * g[0], o[dh][4 * g4 + 1] * rn * g[1]); w.y = cvt_pk_bf16(o[dh][4 * g4 + 2] * rn * g[2], o[dh][4 * g4 + 3] * rn * g[3]);
                    *(u32x2*)(orow + 32 * dh + 8 * g4) = w; } }
    } else {
        bf16* orow = J.O + tok * J.opitch + J.ooff + 4 * hi;
#pragma unroll
        for (int dh = 0; dh < NDH; ++dh)
#pragma unroll
            for (int g4 = 0; g4 < 4; ++g4) {
                u32x2 w; w.x = cvt_pk_bf16(o[dh][4 * g4], o[dh][4 * g4 + 1]); w.y = cvt_pk_bf16(o[dh][4 * g4 + 2], o[dh][4 * g4 + 3]);
                *(u32x2*)(orow + 32 * dh + 8 * g4) = w;
            }
        if (hi == 0) J.L[tok * J.lpitch + J.loff] = lsum;
    }
}

struct JobA { int br, dil, rho, n, lo, nt; };
__device__ __forceinline__ JobA job_a(int j) { JobA q;
    if (j < 16) { q.br = 0; q.rho = 0; q.n = j; q.dil = 1; } else if (j < 32) { q.br = 1; q.rho = (j - 16) >> 2; q.n = (j - 16) & 3; q.dil = 4; } else { q.br = 2; q.rho = j - 32; q.n = 0; q.dil = 16; }
    q.lo = q.n > 0 ? 2 * q.n - 2 : 0; q.nt = q.n > 0 ? 4 : 2; return q; }
__device__ __forceinline__ void unit_a3(LAS unsigned char* lds, const bf16* __restrict__ QKV, const float* __restrict__ RLUT, bf16* PARTA_, float* LA_, int b, int hp, int g) {
    constexpr int LUT3 = LUTO;
    const int tid = opq(threadIdx.x), lane = tid & 63, r32 = lane & 31, hi = lane >> 5;
    const int wid = __builtin_amdgcn_readfirstlane(tid >> 6), hsel = wid >> 2, w4 = wid & 3, head = 2 * hp + hsel;
    const size_t tb = (size_t)b * SEQ;
    const bf16* Qg = QKV + ((size_t)head * NT + tb) * 64;
    const bf16* Kg = QKV + ((size_t)(8 + head) * NT + tb) * 64;
    const bf16* Vg = QKV + ((size_t)(16 + head) * NT + tb) * 64;
    const JobA j0 = job_a(3 * g), j1 = job_a(3 * g + 1), j2 = job_a(3 * g + 2);
    const int c1 = j0.nt, c2 = j0.nt + j1.nt, S = c2 + j2.nt;
#define JSEL(k, f) ((k) == 0 ? j0.f : (k) == 1 ? j1.f : j2.f)
    const unsigned lds0 = (unsigned)(uintptr_t)lds;
    __syncthreads();
#define ATT_LOADS(s_, slot, cbase, ncnt) do { const int k_ = ((s_) >= c1) + ((s_) >= c2); const int kt_ = JSEL(k_, lo) + (s_) - (k_ == 0 ? 0 : k_ == 1 ? c1 : c2); \
        const int k0_ = kt_ * 64, rho_ = JSEL(k_, rho), dil_ = JSEL(k_, dil); \
        _Pragma("unroll") for (int pp = 0; pp < (ncnt); ++pp) { const int c_ = (cbase) + pp; \
            glds16(Kg + (size_t)(rho_ + dil_ * (k0_ + 8 * c_ + (lane >> 3))) * 64 + ((lane & 7) ^ (lane >> 3)) * 8, (unsigned)__builtin_amdgcn_readfirstlane(lds0 + KBUF + (slot) * 16384 + hsel * 8192 + c_ * 1024)); } \
        _Pragma("unroll") for (int pp = 0; pp < (ncnt); ++pp) { const int p_ = (cbase) + pp, dh_ = p_ >> 2, kg_ = p_ & 3; \
            glds16(Vg + (size_t)(rho_ + dil_ * (k0_ + 16 * kg_ + (lane >> 2))) * 64 + dh_ * 32 + (lane & 3) * 8, (unsigned)__builtin_amdgcn_readfirstlane(lds0 + VBUF + (slot) * 16384 + hsel * 8192 + p_ * 1024)); } } while (0)
#define ATT_BAR_VM0() asm volatile("s_waitcnt vmcnt(0) lgkmcnt(0)\n\ts_barrier" ::: "memory")
#define ATT_BAR() asm volatile("s_waitcnt lgkmcnt(0)\n\ts_barrier" ::: "memory")
#define ATT_QLOAD(dst, k) do { const bf16* qrow_ = Qg + (size_t)(JSEL(k, rho) + JSEL(k, dil) * (128 * JSEL(k, n) + 32 * w4 + r32)) * 64 + hi * 8; \
        _Pragma("unroll") for (int d0 = 0; d0 < 4; ++d0) dst[d0] = *(const bf16x8*)(qrow_ + d0 * 16); } while (0)
    const int par = w4 & 1, cb4 = 4 * (w4 >> 1);
    ATT_LOADS(0, 0, 2 * w4, 2);
    if (par == 1) ATT_LOADS(1, 1, cb4, 4);
    bf16x8 qr[4], q1[4], q2[4];
    ATT_QLOAD(qr, 0); ATT_QLOAD(q1, 1); ATT_QLOAD(q2, 2);
    { LAS float* L = (LAS float*)(lds + LUT3 + hsel * (3 * LUTN * 4)); const int i = tid & 255;
#pragma unroll
      for (int k = 0; k < 3; ++k) { const float* src = RLUT + (size_t)(JSEL(k, br) * 8 + head) * LUTN; L[k * LUTN + i] = src[i]; if (i < LUTN - 256) L[k * LUTN + 256 + i] = src[256 + i]; } }
    f32x16 o[2]; o[0] = f32x16{}; o[1] = f32x16{};
    float lsum = 0.f;
    const LAS char* kfb = (const LAS char*)(lds + KBUF + hsel * 8192 + r32 * 128);
    int koff[4];
#pragma unroll
    for (int d0 = 0; d0 < 4; ++d0) koff[d0] = (((2 * d0 + hi) ^ (r32 & 7)) << 4);
    const LAS char* vfb = (const LAS char*)(lds + VBUF + hsel * 8192 + ((lane >> 4) & 1) * 32 + (lane & 3) * 8 + (4 * hi + ((lane & 15) >> 2)) * 64);
    int buf = 0, bufn = 2;
    for (int s = 0; s < S; ++s) {
        if (s == 0 || (s & 1) == par) ATT_BAR_VM0(); else ATT_BAR();
        if ((s & 1) == par && s + 2 < S) ATT_LOADS(s + 2, bufn, cb4, 4);
        const int k = (s >= c1) + (s >= c2), cs = k == 0 ? 0 : k == 1 ? c1 : c2;
        const int kt = JSEL(k, lo) + s - cs, Q0w = 128 * JSEL(k, n) + 32 * w4;
        if (s == cs && k > 0) {
#pragma unroll
            for (int d0 = 0; d0 < 4; ++d0) qr[d0] = (k == 1) ? q1[d0] : q2[d0];
            o[0] = f32x16{}; o[1] = f32x16{}; lsum = 0.f;
        }
        const int dq = Q0w - kt * 64;
        const bool need = (dq >= -31) && (dq <= 191);
        if (need) {
            f32x16 c0, c1;
            { const LAS char* lp = (const LAS char*)(lds + LUT3 + hsel * (3 * LUTN * 4) + k * (LUTN * 4)) + (255 - dq - r32 + 4 * hi) * 4;
#pragma unroll
              for (int r = 0; r < 16; ++r) { const int off = ((r & 3) + 8 * (r >> 2)) * 4; c0[r] = *(const LAS float*)(lp + off); c1[r] = *(const LAS float*)(lp + off + 128); } }
            const LAS char* kp = kfb + buf * 16384;
            const LAS char* vp = vfb + buf * 16384;
            bf16x8 kf[8];
#pragma unroll
            for (int d0 = 0; d0 < 4; ++d0) { kf[2 * d0] = *(const LAS bf16x8*)(kp + koff[d0]); kf[2 * d0 + 1] = *(const LAS bf16x8*)(kp + koff[d0] + 4096); }
            __builtin_amdgcn_sched_barrier(0);
#pragma unroll
            for (int d0 = 0; d0 < 4; ++d0) {
                c0 = __builtin_amdgcn_mfma_f32_32x32x16_bf16(kf[2 * d0], qr[d0], c0, 0, 0, 0);
                c1 = __builtin_amdgcn_mfma_f32_32x32x16_bf16(kf[2 * d0 + 1], qr[d0], c1, 0, 0, 0);
            }
            s16x4 vl[8], vh[8];
#pragma unroll
            for (int i_ = 0; i_ < 8; ++i_) { vl[i_] = vtr(vp + (i_ >> 2) * 4096 + (i_ & 3) * 1024); vh[i_] = vtr(vp + (i_ >> 2) * 4096 + (i_ & 3) * 1024 + 512); }
            float s0 = 0.f, s1 = 0.f;
#pragma unroll
            for (int r = 0; r < 16; ++r) { c0[r] = __builtin_amdgcn_exp2f(c0[r]); c1[r] = __builtin_amdgcn_exp2f(c1[r]); s0 += c0[r]; s1 += c1[r]; }
            lsum += s0 + s1;
            u32x4 pw[4];
#pragma unroll
            for (int q = 0; q < 2; ++q) {
                pw[q] = (u32x4){cvt_pk_bf16(c0[8 * q], c0[8 * q + 1]), cvt_pk_bf16(c0[8 * q + 2], c0[8 * q + 3]), cvt_pk_bf16(c0[8 * q + 4], c0[8 * q + 5]), cvt_pk_bf16(c0[8 * q + 6], c0[8 * q + 7])};
                pw[2 + q] = (u32x4){cvt_pk_bf16(c1[8 * q], c1[8 * q + 1]), cvt_pk_bf16(c1[8 * q + 2], c1[8 * q + 3]), cvt_pk_bf16(c1[8 * q + 4], c1[8 * q + 5]), cvt_pk_bf16(c1[8 * q + 6], c1[8 * q + 7])};
            }
#pragma unroll
            for (int i_ = 0; i_ < 8; ++i_) { const bf16x8 vf_ = (bf16x8){vl[i_][0], vl[i_][1], vl[i_][2], vl[i_][3], vh[i_][0], vh[i_][1], vh[i_][2], vh[i_][3]};
                o[i_ >> 2] = __builtin_amdgcn_mfma_f32_32x32x16_bf16(vf_, __builtin_bit_cast(bf16x8, pw[i_ & 3]), o[i_ >> 2], 0, 0, 0); }
        }
        if (s + 1 == (k == 0 ? c1 : k == 1 ? c2 : S)) {
            float lt = lsum;
            { auto rr = __builtin_amdgcn_permlane32_swap(__float_as_uint(lt), __float_as_uint(lt), false, false); lt = __uint_as_float(rr[0]) + __uint_as_float(rr[1]); }
            const int br = JSEL(k, br);
            const size_t tok = tb + (size_t)(JSEL(k, rho) + JSEL(k, dil) * (Q0w + r32));
            bf16* orow = PARTA_ + ((size_t)br * NT + tok) * 512 + head * 64 + 4 * hi;
#pragma unroll
            for (int dh = 0; dh < 2; ++dh)
#pragma unroll
                for (int g4 = 0; g4 < 4; ++g4) {
                    u32x2 w; w.x = cvt_pk_bf16(o[dh][4 * g4], o[dh][4 * g4 + 1]); w.y = cvt_pk_bf16(o[dh][4 * g4 + 2], o[dh][4 * g4 + 3]);
                    *(u32x2*)(orow + 32 * dh + 8 * g4) = w;
                }
            if (hi == 0) LA_[((size_t)br * NT + tok) * 8 + head] = lt;
        }
        bufn = buf; buf = (buf == 2) ? 0 : buf + 1;
    }
    asm volatile("s_waitcnt lgkmcnt(0)" ::: "memory");
#undef ATT_LOADS
#undef ATT_BAR_VM0
#undef ATT_BAR
#undef ATT_QLOAD
#undef JSEL
}
__device__ __forceinline__ void unit_a12(LAS unsigned char* lds, const bf16* __restrict__ QKV, const float* __restrict__ RLUT, bf16* PARTA_, float* LA_, int b, int hp, int q) {
    constexpr int LUT3 = LUTO;
    const int tid = opq(threadIdx.x), lane = tid & 63, r32 = lane & 31, hi = lane >> 5;
    const int wid = __builtin_amdgcn_readfirstlane(tid >> 6), hsel = wid >> 2, w4 = wid & 3, head = 2 * hp + hsel;
    const size_t tb = (size_t)b * SEQ;
    const bf16* Qg = QKV + ((size_t)head * NT + tb) * 64;
    const bf16* Kg = QKV + ((size_t)(8 + head) * NT + tb) * 64;
    const bf16* Vg = QKV + ((size_t)(16 + head) * NT + tb) * 64;
#define JID(jj) (3 * (q + 4 * ((jj) / 3)) + (jj) % 3)
    int S = 0;
    for (int jj = 0; jj < 12; ++jj) S += job_a(JID(jj)).nt;
    int kl = 0, csl = 0; JobA jl = job_a(JID(0)); int cel = jl.nt;
#define ATT_LC_ADV(s_) do { if ((s_) >= cel && kl + 1 < 12) { ++kl; jl = job_a(JID(kl)); csl = cel; cel += jl.nt; } } while (0)
    const unsigned lds0 = (unsigned)(uintptr_t)lds;
    __syncthreads();
#define ATT_LOADS(s_, slot, cbase, ncnt) do { const int kt_ = jl.lo + (s_) - csl; \
        const int k0_ = kt_ * 64, rho_ = jl.rho, dil_ = jl.dil; \
        _Pragma("unroll") for (int pp = 0; pp < (ncnt); ++pp) { const int c_ = (cbase) + pp; \
            glds16(Kg + (size_t)(rho_ + dil_ * (k0_ + 8 * c_ + (lane >> 3))) * 64 + ((lane & 7) ^ (lane >> 3)) * 8, (unsigned)__builtin_amdgcn_readfirstlane(lds0 + KBUF + (slot) * 16384 + hsel * 8192 + c_ * 1024)); } \
        _Pragma("unroll") for (int pp = 0; pp < (ncnt); ++pp) { const int p_ = (cbase) + pp, dh_ = p_ >> 2, kg_ = p_ & 3; \
            glds16(Vg + (size_t)(rho_ + dil_ * (k0_ + 16 * kg_ + (lane >> 2))) * 64 + dh_ * 32 + (lane & 3) * 8, (unsigned)__builtin_amdgcn_readfirstlane(lds0 + VBUF + (slot) * 16384 + hsel * 8192 + p_ * 1024)); } } while (0)
#define ATT_BAR_VM0() asm volatile("s_waitcnt vmcnt(0) lgkmcnt(0)\n\ts_barrier" ::: "memory")
#define ATT_BAR() asm volatile("s_waitcnt lgkmcnt(0)\n\ts_barrier" ::: "memory")
#define ATT_QLOAD(dst, J_) do { const bf16* qrow_ = Qg + (size_t)(J_.rho + J_.dil * (128 * J_.n + 32 * w4 + r32)) * 64 + hi * 8; \
        _Pragma("unroll") for (int d0 = 0; d0 < 4; ++d0) asm volatile("global_load_dwordx4 %0, %1, off" : "=&v"(dst[d0]) : "v"(qrow_ + d0 * 16) : "memory"); } while (0)
    const int par = w4 & 1, cb4 = 4 * (w4 >> 1);
    ATT_LOADS(0, 0, 2 * w4, 2);
    ATT_LC_ADV(1);
    if (par == 1) ATT_LOADS(1, 1, cb4, 4);
    int kc = 0, csc = 0; JobA jc = job_a(JID(0)), jn = job_a(JID(1)); int cec = jc.nt;
    bf16x8 qr[4], qn[4];
    ATT_QLOAD(qr, jc); ATT_QLOAD(qn, jn);
    { LAS float* L = (LAS float*)(lds + LUT3 + hsel * (3 * LUTN * 4)); const int i = tid & 255;
#pragma unroll
      for (int k = 0; k < 3; ++k) { const float* src = RLUT + (size_t)(k * 8 + head) * LUTN; L[k * LUTN + i] = src[i]; if (i < LUTN - 256) L[k * LUTN + 256 + i] = src[256 + i]; } }
    f32x16 o[2]; o[0] = f32x16{}; o[1] = f32x16{};
    float lsum = 0.f;
    const LAS char* kfb = (const LAS char*)(lds + KBUF + hsel * 8192 + r32 * 128);
    int koff[4];
#pragma unroll
    for (int d0 = 0; d0 < 4; ++d0) koff[d0] = (((2 * d0 + hi) ^ (r32 & 7)) << 4);
    const LAS char* vfb = (const LAS char*)(lds + VBUF + hsel * 8192 + ((lane >> 4) & 1) * 32 + (lane & 3) * 8 + (4 * hi + ((lane & 15) >> 2)) * 64);
    int buf = 0, bufn = 2;
    for (int s = 0; s < S; ++s) {
        if (s == 0 || (s & 1) == par) ATT_BAR_VM0(); else ATT_BAR();
        ATT_LC_ADV(s + 2);
        if ((s & 1) == par && s + 2 < S) ATT_LOADS(s + 2, bufn, cb4, 4);
        if (s == cec) {
            ++kc; jc = jn; csc = cec; cec += jc.nt;
#pragma unroll
            for (int d0 = 0; d0 < 4; ++d0) { asm volatile("" : "+v"(qn[d0])); qr[d0] = qn[d0]; }
            o[0] = f32x16{}; o[1] = f32x16{}; lsum = 0.f;
            if (kc + 1 < 12) { jn = job_a(JID(kc + 1)); ATT_QLOAD(qn, jn); }
        }
        const int kt = jc.lo + s - csc, Q0w = 128 * jc.n + 32 * w4;
        const int dq = Q0w - kt * 64;
        const bool need = (dq >= -31) && (dq <= 191);
        if (need) {
            f32x16 c0, c1;
            { unsigned lpo_ = (unsigned)(uintptr_t)((const LAS char*)(lds + LUT3 + hsel * (3 * LUTN * 4) + jc.br * (LUTN * 4)) + (255 - dq - r32 + 4 * hi) * 4); asm volatile("" : "+v"(lpo_));
              const LAS char* lp = (const LAS char*)(uintptr_t)lpo_;
#pragma unroll
              for (int r = 0; r < 16; ++r) { const int off = ((r & 3) + 8 * (r >> 2)) * 4; c0[r] = *(const LAS float*)(lp + off); c1[r] = *(const LAS float*)(lp + off + 128); } }
            const LAS char* kp = kfb + buf * 16384;
            const LAS char* vp = vfb + buf * 16384;
            bf16x8 kf[8];
#pragma unroll
            for (int d0 = 0; d0 < 4; ++d0) { kf[2 * d0] = *(const LAS bf16x8*)(kp + koff[d0]); kf[2 * d0 + 1] = *(const LAS bf16x8*)(kp + koff[d0] + 4096); }
            __builtin_amdgcn_sched_barrier(0);
#pragma unroll
            for (int d0 = 0; d0 < 4; ++d0) {
                c0 = __builtin_amdgcn_mfma_f32_32x32x16_bf16(kf[2 * d0], qr[d0], c0, 0, 0, 0);
                c1 = __builtin_amdgcn_mfma_f32_32x32x16_bf16(kf[2 * d0 + 1], qr[d0], c1, 0, 0, 0);
            }
            s16x4 vl[8], vh[8];
#pragma unroll
            for (int i_ = 0; i_ < 8; ++i_) { vl[i_] = vtr(vp + (i_ >> 2) * 4096 + (i_ & 3) * 1024); vh[i_] = vtr(vp + (i_ >> 2) * 4096 + (i_ & 3) * 1024 + 512); }
            float s0 = 0.f, s1 = 0.f;
#pragma unroll
            for (int r = 0; r < 16; ++r) { c0[r] = __builtin_amdgcn_exp2f(c0[r]); c1[r] = __builtin_amdgcn_exp2f(c1[r]); s0 += c0[r]; s1 += c1[r]; }
            lsum += s0 + s1;
            u32x4 pw[4];
#pragma unroll
            for (int q = 0; q < 2; ++q) {
                pw[q] = (u32x4){cvt_pk_bf16(c0[8 * q], c0[8 * q + 1]), cvt_pk_bf16(c0[8 * q + 2], c0[8 * q + 3]), cvt_pk_bf16(c0[8 * q + 4], c0[8 * q + 5]), cvt_pk_bf16(c0[8 * q + 6], c0[8 * q + 7])};
                pw[2 + q] = (u32x4){cvt_pk_bf16(c1[8 * q], c1[8 * q + 1]), cvt_pk_bf16(c1[8 * q + 2], c1[8 * q + 3]), cvt_pk_bf16(c1[8 * q + 4], c1[8 * q + 5]), cvt_pk_bf16(c1[8 * q + 6], c1[8 * q + 7])};
            }
#pragma unroll
            for (int i_ = 0; i_ < 8; ++i_) { const bf16x8 vf_ = (bf16x8){vl[i_][0], vl[i_][1], vl[i_][2], vl[i_][3], vh[i_][0], vh[i_][1], vh[i_][2], vh[i_][3]};
                o[i_ >> 2] = __builtin_amdgcn_mfma_f32_32x32x16_bf16(vf_, __builtin_bit_cast(bf16x8, pw[i_ & 3]), o[i_ >> 2], 0, 0, 0); }
        }
        if (s + 1 == cec) {
            float lt = lsum;
            { auto rr = __builtin_amdgcn_permlane32_swap(__float_as_uint(lt), __float_as_uint(lt), false, false); lt = __uint_as_float(rr[0]) + __uint_as_float(rr[1]); }
            const int br = jc.br;
            const size_t tok = tb + (size_t)(jc.rho + jc.dil * (Q0w + r32));
            bf16* orow = PARTA_ + ((size_t)br * NT + tok) * 512 + head * 64 + 4 * hi;
#pragma unroll
            for (int dh = 0; dh < 2; ++dh)
#pragma unroll
                for (int g4 = 0; g4 < 4; ++g4) {
                    u32x2 w; w.x = cvt_pk_bf16(o[dh][4 * g4], o[dh][4 * g4 + 1]); w.y = cvt_pk_bf16(o[dh][4 * g4 + 2], o[dh][4 * g4 + 3]);
                    *(u32x2*)(orow + 32 * dh + 8 * g4) = w;
                }
            if (hi == 0) LA_[((size_t)br * NT + tok) * 8 + head] = lt;
        }
        bufn = buf; buf = (buf == 2) ? 0 : buf + 1;
    }
    asm volatile("s_waitcnt lgkmcnt(0)" ::: "memory");
#undef ATT_LOADS
#undef ATT_BAR_VM0
#undef ATT_BAR
#undef ATT_QLOAD
#undef JID
#undef ATT_LC_ADV
}
}

#define XB_TMO      128
#define XB_XCNT(j)  (256  + 64 * (j))
#define XB_XSUB(j)  (1280 + 64 * (j))
#define XB_XGEN(j)  (2304 + 64 * (j))
#define XB_TOP      3328
#define XB_TOPGEN   3392
#define XCD_BAR_WORDS 3456
#define XB_SPIN_CAP (1u << 18)
__device__ __forceinline__ unsigned xb_ld(unsigned* p)              { return __hip_atomic_load(p, __ATOMIC_RELAXED, __HIP_MEMORY_SCOPE_AGENT); }
__device__ __forceinline__ unsigned xb_add(unsigned* p, unsigned v) { return __hip_atomic_fetch_add(p, v, __ATOMIC_RELAXED, __HIP_MEMORY_SCOPE_AGENT); }
__device__ __forceinline__ unsigned xb_xcc_id() { return (unsigned)__builtin_amdgcn_s_getreg((3 << 11) | 20) & 0xFu; }
#define XB_SPIN(cond, bar) do { unsigned _sp = 0; while (cond) { __builtin_amdgcn_s_sleep(1); \
    if ((++_sp & 255u) == 0u) { if (xb_ld(&(bar)[XB_TMO])) break; if (_sp > XB_SPIN_CAP) { atomicAdd(&(bar)[XB_TMO], 1u); break; } } } } while (0)
struct XcdBarrier { unsigned* bar; unsigned x; volatile LAS unsigned* st; };
__device__ __forceinline__ XcdBarrier xcd_barrier_post(unsigned* bar, volatile LAS unsigned* st) {
    XcdBarrier b; b.bar = bar; b.x = xb_xcc_id(); b.st = st;
    if (threadIdx.x == 0) (void)xb_add(&bar[XB_XCNT(b.x)], 1u);
    return b;
}
__device__ __forceinline__ void xcd_barrier_complete(unsigned* bar, unsigned x, unsigned& nloc, unsigned& nx) {
    const unsigned G = gridDim.x * gridDim.y * gridDim.z;
    unsigned sum, cnt, mine, sp = 0u;
    for (;;) {
        sum = 0u; cnt = 0u; mine = 0u;
#pragma unroll
        for (unsigned j = 0; j < 16; ++j) { const unsigned c = xb_ld(&bar[XB_XCNT(j)]); sum += c; cnt += (c > 0u) ? 1u : 0u; mine = (j == x) ? c : mine; }
        if (sum == G) break;
        __builtin_amdgcn_s_sleep(1);
        if ((++sp & 255u) == 0u) { if (xb_ld(&bar[XB_TMO])) break; if (sp > XB_SPIN_CAP) { atomicAdd(&bar[XB_TMO], 1u); break; } }
    }
    nloc = mine > 0u ? mine : 1u; nx = cnt > 0u ? cnt : 1u;
}
__device__ __forceinline__ void xcd_barrier(const XcdBarrier& b) {
    asm volatile("s_waitcnt vmcnt(0)" ::: "memory");
    __syncthreads();
    if (threadIdx.x == 0) {
        unsigned* bar = b.bar;
        __builtin_amdgcn_s_waitcnt(0);
        unsigned nloc = b.st[0], nx = b.st[1];
        if (nloc == 0u) { xcd_barrier_complete(bar, b.x, nloc, nx); b.st[0] = nloc; b.st[1] = nx; }
        const unsigned old = xb_add(&bar[XB_XSUB(b.x)], 1u);
        const unsigned gen = old / nloc;
        if (old + 1u == (gen + 1u) * nloc) {
            __builtin_amdgcn_fence(__ATOMIC_RELEASE, "agent");
            asm volatile("s_waitcnt vmcnt(0)" ::: "memory");
            const unsigned og = xb_add(&bar[XB_TOP], 1u);
            const unsigned tg = og / nx;
            if (og + 1u == (tg + 1u) * nx) xb_add(&bar[XB_TOPGEN], 1u);
            else XB_SPIN(xb_ld(&bar[XB_TOPGEN]) == tg, bar);
            __builtin_amdgcn_fence(__ATOMIC_ACQUIRE, "agent");
            xb_add(&bar[XB_XGEN(b.x)], 1u);
            asm volatile("s_waitcnt vmcnt(0)" ::: "memory");
        } else {
            XB_SPIN(xb_ld(&bar[XB_XGEN(b.x)]) == gen, bar);
            __builtin_amdgcn_fence(__ATOMIC_ACQUIRE, "agent");
            asm volatile("s_waitcnt vmcnt(0)" ::: "memory");
        }
    }
    __syncthreads();
}

struct Args { const float* in[22]; float* out; unsigned char* ws; int ph_lo, ph_hi; };
static_assert(sizeof(Args) == 22 * 8 + 8 + 8 + 8, "no padding in Args");

struct CvtItem { const float* src; bf16* dst; int ldn, Kd, r0, r1; const float* gk; };
__device__ __forceinline__ void cvt_load(f32x4 (&r)[16], f32x2 (&gq)[8], const CvtItem& I, int lane, const float* gdummy) {
    const float* p = I.src + (size_t)(2 * (lane >> 4)) * I.ldn + 4 * (lane & 15);
#pragma unroll
    for (int i = 0; i < 8; ++i)
#pragma unroll
        for (int t = 0; t < 2; ++t) asm volatile("global_load_dwordx4 %0, %1, off nt" : "=&v"(r[2 * i + t]) : "v"(p + (size_t)(8 * i + t) * I.ldn) : "memory");
    const float* gp = (I.gk ? I.gk : gdummy) + 2 * (lane >> 4);
#pragma unroll
    for (int i = 0; i < 8; ++i) asm volatile("global_load_dwordx2 %0, %1, off" : "=&v"(gq[i]) : "v"(gp + 8 * i) : "memory");
}
__device__ __forceinline__ void cvt_proc(const f32x4 (&r)[16], const f32x2 (&gq)[8], const CvtItem& I, LAS unsigned* scr, int lane) {
    const int g = lane >> 4, nl = 4 * (lane & 15);
#pragma unroll
    for (int i = 0; i < 8; ++i)
#pragma unroll
        for (int c = 0; c < 4; ++c) { const float ga = I.gk ? gq[i][0] : 1.f, gb = I.gk ? gq[i][1] : 1.f; scr[(nl + c) * 33 + 4 * i + g] = pk2(r[2 * i][c] * ga, r[2 * i + 1][c] * gb); }
    LDS_WAIT(); asm volatile("" ::: "memory");
    const int c8 = lane & 7;
#pragma unroll
    for (int j = 0; j < 8; ++j) { const int n = 8 * j + (lane >> 3); const LAS unsigned* q = scr + n * 33 + 4 * c8;
        u32x4 o; o.x = q[0]; o.y = q[1]; o.z = q[2]; o.w = q[3];
        const int row = (n < 32 ? I.r0 + n : I.r1 + n - 32);
        *(u32x4*)(I.dst + (size_t)row * I.Kd + 8 * c8) = o; }
    LDS_WAIT(); asm volatile("" ::: "memory");
}
#define CVT_TOUCHG(R_, G_) do { _Pragma("unroll") for (int z_ = 0; z_ < 16; ++z_) asm volatile("" : "+v"(R_[z_])); _Pragma("unroll") for (int z_ = 0; z_ < 8; ++z_) asm volatile("" : "+v"(G_[z_])); } while (0)
#define CVT_RUN(NITEMS_, DEC, GDUMMY_) do { f32x4 ra_[16], rb_[16]; f32x2 ga_[8], gb_[8]; int it_ = gw; CvtItem Ia_, Ib_; \
    _Pragma("unroll") for (int z_ = 0; z_ < 16; ++z_) { ra_[z_] = (f32x4){0.f, 0.f, 0.f, 0.f}; rb_[z_] = ra_[z_]; } \
    _Pragma("unroll") for (int z_ = 0; z_ < 8; ++z_) { ga_[z_] = (f32x2){0.f, 0.f}; gb_[z_] = ga_[z_]; } Ia_ = DEC(0); Ib_ = Ia_; \
    if (it_ < (NITEMS_)) { Ia_ = DEC(it_); cvt_load(ra_, ga_, Ia_, lane, (GDUMMY_)); } \
    while (it_ < (NITEMS_)) { int it2_ = it_ + NGW; \
        if (it2_ < (NITEMS_)) { Ib_ = DEC(it2_); cvt_load(rb_, gb_, Ib_, lane, (GDUMMY_)); asm volatile("s_waitcnt vmcnt(24)" ::: "memory"); } else asm volatile("s_waitcnt vmcnt(0)" ::: "memory"); \
        CVT_TOUCHG(ra_, ga_); cvt_proc(ra_, ga_, Ia_, scr, lane); it_ = it2_; if (!(it_ < (NITEMS_))) break; \
        it2_ = it_ + NGW; if (it2_ < (NITEMS_)) { Ia_ = DEC(it2_); cvt_load(ra_, ga_, Ia_, lane, (GDUMMY_)); asm volatile("s_waitcnt vmcnt(24)" ::: "memory"); } else asm volatile("s_waitcnt vmcnt(0)" ::: "memory"); \
        CVT_TOUCHG(rb_, gb_); cvt_proc(rb_, gb_, Ib_, scr, lane); it_ = it2_; } } while (0)

struct CvtItem8 { const float* src; unsigned char* dst; int ldn, Kd, r0, r1; float scale; };
__device__ __forceinline__ void cvt_load4(f32x4 (&r)[16], const CvtItem8& I, int lane) {
    const float* p = I.src + (size_t)(4 * (lane >> 3)) * I.ldn + 4 * (lane & 7);
#pragma unroll
    for (int i = 0; i < 4; ++i)
#pragma unroll
        for (int t = 0; t < 4; ++t) asm volatile("global_load_dwordx4 %0, %1, off nt" : "=&v"(r[4 * i + t]) : "v"(p + (size_t)(32 * i + t) * I.ldn) : "memory");
}
__device__ __forceinline__ void cvt_proc8(const f32x4 (&r)[16], const CvtItem8& I, LAS unsigned* scr, int lane) {
    const int g = lane >> 3, nl = 4 * (lane & 7); const float sc = I.scale;
#pragma unroll
    for (int i = 0; i < 4; ++i)
#pragma unroll
        for (int c = 0; c < 4; ++c) scr[(nl + c) * 33 + 8 * i + g] = pg8::pk4_fp8(r[4 * i][c] * sc, r[4 * i + 1][c] * sc, r[4 * i + 2][c] * sc, r[4 * i + 3][c] * sc);
    LDS_WAIT(); asm volatile("" ::: "memory");
    const int c8 = lane & 7;
#pragma unroll
    for (int j = 0; j < 4; ++j) { const int n = 8 * j + (lane >> 3); const LAS unsigned* q = scr + n * 33 + 4 * c8;
        u32x4 o; o.x = q[0]; o.y = q[1]; o.z = q[2]; o.w = q[3];
        *(u32x4*)(I.dst + (size_t)(I.r0 + n) * I.Kd + 16 * c8) = o; }
    LDS_WAIT(); asm volatile("" ::: "memory");
}
#define CVT_TOUCH(R_) do { _Pragma("unroll") for (int z_ = 0; z_ < 16; ++z_) asm volatile("" : "+v"(R_[z_])); } while (0)
#define CVT_RUN8(NITEMS_, DEC) do { f32x4 ra_[16], rb_[16]; int it_ = gw; CvtItem8 Ia_, Ib_; \
    _Pragma("unroll") for (int z_ = 0; z_ < 16; ++z_) { ra_[z_] = (f32x4){0.f, 0.f, 0.f, 0.f}; rb_[z_] = ra_[z_]; } Ia_ = DEC(0); Ib_ = Ia_; \
    if (it_ < (NITEMS_)) { Ia_ = DEC(it_); cvt_load4(ra_, Ia_, lane); } \
    while (it_ < (NITEMS_)) { int it2_ = it_ + NGW; \
        if (it2_ < (NITEMS_)) { Ib_ = DEC(it2_); cvt_load4(rb_, Ib_, lane); asm volatile("s_waitcnt vmcnt(16)" ::: "memory"); } else asm volatile("s_waitcnt vmcnt(0)" ::: "memory"); \
        CVT_TOUCH(ra_); cvt_proc8(ra_, Ia_, scr, lane); it_ = it2_; if (!(it_ < (NITEMS_))) break; \
        it2_ = it_ + NGW; if (it2_ < (NITEMS_)) { Ia_ = DEC(it2_); cvt_load4(ra_, Ia_, lane); asm volatile("s_waitcnt vmcnt(16)" ::: "memory"); } else asm volatile("s_waitcnt vmcnt(0)" ::: "memory"); \
        CVT_TOUCH(rb_); cvt_proc8(rb_, Ib_, scr, lane); it_ = it2_; } } while (0)

__device__ __forceinline__ void rms_row_to_bf16(const float* xrow, const float* g, bf16* orow, int lane, f32x4 (&v)[4]) {
    const f32x4* xr = (const f32x4*)xrow + lane; float s = 0.f;
#pragma unroll
    for (int j = 0; j < 4; ++j) { v[j] = xr[64 * j]; s += (v[j][0] * v[j][0] + v[j][1] * v[j][1]) + (v[j][2] * v[j][2] + v[j][3] * v[j][3]); }
    const float r = 1.0f / sqrtf(wave_sum(s) * (1.f / D) + EPS);
    unsigned long long* o8 = (unsigned long long*)orow + lane;
#pragma unroll
    for (int j = 0; j < 4; ++j) { const f32x4 gg = ((const f32x4*)g)[lane + 64 * j]; v[j] = v[j] * r * gg;
        o8[64 * j] = (unsigned long long)pk2(v[j][0], v[j][1]) | ((unsigned long long)pk2(v[j][2], v[j][3]) << 32); }
}

__global__ void __launch_bounds__(NWAVES * 64, 2) fwd_kernel(Args args) {
    extern __shared__ __attribute__((aligned(16))) unsigned char lds_raw[];
    LAS unsigned char* lds = (LAS unsigned char*)lds_raw;
    volatile LAS unsigned* MISC = (volatile LAS unsigned*)(lds + MISC_OFF);
    int tid = threadIdx.x, lane = tid & 63; const int wave = __builtin_amdgcn_readfirstlane(tid >> 6);
    const int G = gridDim.x, blk = blockIdx.x;
    unsigned char* ws = args.ws;
    unsigned* ctl = (unsigned*)(ws + WS_CTL);
    for (int u = tid; u < (LDS_BYTES - LDSCTL_OFF) / 4; u += NWAVES * 64) ((LAS unsigned*)(lds + LDSCTL_OFF))[u] = 0u;
    __syncthreads();
    XcdBarrier bar = xcd_barrier_post(ctl + CW_BAR, MISC + 8);

    const float* x_in = args.in[0];
    float* xs = args.out;
    unsigned char* wsq = ws;
#define XN ((bf16*)(wsq + WS_XN))
#define QKV ((bf16*)(wsq + WS_QKV))
#define PARTA ((bf16*)(wsq + WS_PARTA))
#define PARTB ((bf16*)(wsq + WS_PARTB))
#define LA ((float*)(wsq + WS_LA))
#define LB ((float*)(wsq + WS_LB))
#define RLUT ((float*)(wsq + WS_LUT))
#define SCAL ((float*)(wsq + WS_SCAL))
#define HIST ((int*)(wsq + WS_HIST))
#define META ((int*)(wsq + WS_META))
#define TOKE ((int*)(wsq + WS_TOKE))
#define TOKG ((float*)(wsq + WS_TOKG))
#define PSLOT ((int*)(wsq + WS_PSLOT))
#define ROWTOK ((int*)(wsq + WS_ROWTOK))
    const int gw = blk * NWAVES + wave, NGW = G * NWAVES;

    const int lo = args.ph_lo, hi_ph = args.ph_hi; int pc = 0;
#define PH_ON (tid = opq(threadIdx.x), lane = tid & 63, wsq = opq_p(args.ws), pc >= lo && pc < hi_ph)
#ifdef PROBE_DUP
#define NREP(k, extra) ((PROBE_DUP == (k) && (extra)) ? 2 : 1)
#else
#define NREP(k, extra) 1
#endif
#define PH_REP(k, extra) for (int rep_ = 0; rep_ < NREP(k, extra); ++rep_, (rep_ < NREP(k, extra) ? xcd_barrier(bar) : (void)0))
#define PH_END do { if (pc >= lo && pc + 1 < hi_ph) xcd_barrier(bar); ++pc; } while (0)

    if (PH_ON) PH_REP(0, true) {
        LAS unsigned* scr = (LAS unsigned*)(lds + wave * 16384);
        constexpr int I_IN = 16 * 48, I_OUT = 16 * 16, I_GD = 16 * 44, I_DD = 44 * 16;
        constexpr int NITEMS = 2 * I_IN + 2 * I_OUT + 2 * I_GD + I_DD;
        auto dec0 = [&](int it) -> CvtItem { CvtItem I; int r = it;
            if (r < 2 * I_IN) { const int l = r / I_IN; r %= I_IN; const int kb = r / 48, nb = 2 * (r % 48), tile = nb >> 3, ob = nb & 7;
                I.src = args.in[3] + (size_t)l * D * PROJ + (size_t)(64 * kb) * PROJ + 32 * nb; I.ldn = PROJ; I.dst = (bf16*)(wsq + WS_WIN) + (size_t)l * PROJ * D + 64 * kb; I.Kd = D;
                I.r0 = tile * 256 + (ob >> 1) * 32; I.r1 = I.r0 + 128; I.gk = args.in[1] + l * D + 64 * kb; return I; }
            r -= 2 * I_IN;
            if (r < 2 * I_OUT) { const int l = r / I_OUT; r %= I_OUT; const int kb = r / 16, nb = r % 16;
                I.src = args.in[4] + (size_t)l * D * D + (size_t)(64 * kb) * D + 64 * nb; I.ldn = D; I.dst = (bf16*)(wsq + WS_WOUT) + (size_t)l * D * D + 64 * kb; I.Kd = D; I.r0 = 64 * nb; I.r1 = I.r0 + 32; I.gk = nullptr; return I; }
            r -= 2 * I_OUT;
            if (r < 2 * I_GD) { const int up = r / I_GD; r %= I_GD; const int kb = r / 44, nb = r % 44;
                I.src = args.in[15 + up] + (size_t)(64 * kb) * DFF + 64 * nb; I.ldn = DFF; I.dst = (bf16*)(wsq + WS_WGUD) + 64 * kb; I.Kd = D; I.r0 = (nb >> 1) * 256 + up * 128 + (nb & 1) * 64; I.r1 = I.r0 + 32; I.gk = args.in[2] + 64 * kb; return I; }
            r -= 2 * I_GD;
            { const int kb = r / 16, nb = r % 16; I.src = args.in[17] + (size_t)(64 * kb) * D + 64 * nb; I.ldn = D; I.dst = (bf16*)(wsq + WS_WDND) + 64 * kb; I.Kd = DFF; I.r0 = 64 * nb; I.r1 = I.r0 + 32; I.gk = nullptr; return I; } };
        CVT_RUN(NITEMS, dec0, args.in[1]);
        __syncthreads();
        LAS unsigned* red = (LAS unsigned*)(lds);
        if (tid < 2) red[tid] = 0u;
        __syncthreads();
        { float gm = 0.f, bm = 0.f;
          for (int i = tid; i < 4 * 2 * 64; i += NWAVES * 64) gm = fmaxf(gm, fabsf(args.in[5 + (i >> 7)][i & 127]));
          for (int i = tid; i < 32 * 12; i += NWAVES * 64) bm = fmaxf(bm, fabsf(args.in[14][i]));
          atomicMax((unsigned*)&red[0], __float_as_uint(gm)); atomicMax((unsigned*)&red[1], __float_as_uint(bm)); }
        __syncthreads();
        const float gmax = __uint_as_float(red[0]), bmax = __uint_as_float(red[1]);
        const float M2 = (8.f * gmax * gmax * 1.01f + bmax + 0.5f) * LOG2E;
        for (int e = blk * (NWAVES * 64) + tid; e < 28 * att::LUTN; e += G * NWAVES * 64) {
            const int id = e / att::LUTN, j = e % att::LUTN, s = (383 - j) - 128;
            float v = -INFINITY;
            if (id < 24) { const int br = id >> 3, h = id & 7, dil = br == 0 ? 1 : br == 1 ? 4 : 16;
                if (s >= 0 && s <= 128) { const int dist = s * dil; v = args.in[14][t5_bucket(dist < 128 ? dist : 128) * 12 + h] * LOG2E - M2; } }
            else { const int h = id - 24; if (s >= 0) v = args.in[14][t5_bucket(s < 128 ? s : 128) * 12 + 8 + h] * LOG2E - M2; }
            RLUT[e] = v;
        }
        if (blk == 0 && wave < 2) { const int l = wave;
            const float d1 = wave_sum(args.in[9][l * 64 + lane] * args.in[10][l * 64 + lane]), d2 = wave_sum(args.in[11][l * 64 + lane] * args.in[12][l * 64 + lane]);
            const float lam_init = 0.8f - 0.6f * expf(-0.3f * (float)l);
            if (lane == 0) { SCAL[l * 4 + 0] = expf(d1) - expf(d2) + lam_init; SCAL[l * 4 + 1] = 1.f - lam_init; } }
        for (int i = blk * (NWAVES * 64) + tid; i < MAXTILES * 256; i += G * NWAVES * 64) ROWTOK[i] = 0;
        { bf16* XB0 = (bf16*)(wsq + WS_XB); float* RSS0 = (float*)(wsq + WS_RSS);
          for (int m = gw; m < NT; m += 4 * NGW) { f32x4 v[4][4];
#pragma unroll
              for (int q = 0; q < 4; ++q) { const f32x4* xr = (const f32x4*)(x_in + (size_t)min(m + q * NGW, NT - 1) * D) + lane;
#pragma unroll
                  for (int j = 0; j < 4; ++j) v[q][j] = __builtin_nontemporal_load(xr + 64 * j); }
#pragma unroll
              for (int q = 0; q < 4; ++q) { if (m + q * NGW >= NT) break; float ss = 0.f;
#pragma unroll
                  for (int j = 0; j < 4; ++j) ss += (v[q][j][0] * v[q][j][0] + v[q][j][1] * v[q][j][1]) + (v[q][j][2] * v[q][j][2] + v[q][j][3] * v[q][j][3]);
                  ss = wave_sum(ss);
                  if (lane < 16) RSS0[(size_t)(m + q * NGW) * 16 + lane] = lane == 0 ? ss : 0.f;
                  unsigned long long* o8 = (unsigned long long*)(XB0 + (size_t)(m + q * NGW) * D) + lane;
#pragma unroll
                  for (int j = 0; j < 4; ++j) { const f32x4 t = v[q][j];
                      o8[64 * j] = (unsigned long long)pk2(t[0], t[1]) | ((unsigned long long)pk2(t[2], t[3]) << 32); } } } }
    }
    PH_END;

#pragma nounroll
    for (int layer = 0; layer < 2; ++layer) {
        if (PH_ON) PH_REP(1, true) {
            pg8::Gemm g{(const bf16*)(wsq + WS_XB), (const bf16*)(wsq + WS_WIN) + (size_t)layer * PROJ * D, D, nullptr};
            pg8::StaticOrder S; S.init(NT, PROJ, G, blk);
            pg8::EpiQKV E{QKV, {args.in[5] + layer * 64, args.in[6] + layer * 64, args.in[7] + layer * 64, args.in[8] + layer * 64}, (const float*)(wsq + WS_RSS)};

#ifndef SKIP_QKV
            pg8::gemm_phase<pg8::EpiQKV, pg8::StaticOrder, false>(lds, g, S, E);
#endif

        }
        PH_END;
        if (PH_ON) PH_REP(2, true) {
            const int hsel = wave >> 2;
            const float lam_l = SCAL[layer * 4 + 0], oml_l = SCAL[layer * 4 + 1];
            for (int rb_ = 0; rb_ < NREP(20, true); ++rb_)
            for (int u = blk; u < 1024; u += G) {
                const int c = u & 255, i = u >> 8, idx = c >> 3, bh = (c & 7) * 8 + (idx >> 2), qq = idx & 3, n = i == 0 ? qq : i == 1 ? 7 - qq : i == 2 ? 8 + qq : 15 - qq;
                const int b = bh >> 2, h = bh & 3, vh = 2 * h + hsel;
                att::Job J; J.b = b; J.dil = 1; J.rho = 0; J.U0 = 128 * n; J.kt_lo = 0; J.kt_hi = 2 * n + 2;
                J.qG = 24 + vh; J.kG = 32 + vh; J.vG = 40 + 2 * h + hsel; J.lutid = 24 + h;
                J.O = XN; J.opitch = 1024; J.ooff = 512 + h * 128; J.L = nullptr; J.lpitch = 0; J.loff = 0; J.lam = lam_l; J.oml = oml_l; J.sg = args.in[13] + layer * 128;

#ifndef SKIP_ATTB
                att::unit<128, false>(lds, QKV, RLUT, J);
#endif

            }
            for (int ra_ = 0; ra_ < NREP(21, true); ++ra_)
            for (int u = blk; u < 256; u += G) {
                const int hp = u & 3, b = (u >> 2) & 15, q = u >> 6;
                att::unit_a12(lds, QKV, RLUT, PARTA, LA, b, hp, q);
            }
            __syncthreads();
        }
        PH_END;
        if (PH_ON) PH_REP(3, true) {
            for (int t = gw; t < NT; t += NGW) {
                const int h = lane >> 3; float acc[8]; float l = 0.f;
#pragma unroll
                for (int k = 0; k < 8; ++k) acc[k] = 0.f;
#pragma unroll
                for (int br = 0; br < 3; ++br) {
                    const u32x4 a = *(const u32x4*)(PARTA + ((size_t)br * NT + t) * 512 + lane * 8);
                    const unsigned w[4] = {a.x, a.y, a.z, a.w};
#pragma unroll
                    for (int k = 0; k < 4; ++k) { acc[2 * k] += bflo(w[k]); acc[2 * k + 1] += bfhi(w[k]); }
                    l += LA[((size_t)br * NT + t) * 8 + h];
                }
                const float rl = 1.f / l;
                *(u32x4*)(XN + (size_t)t * D + lane * 8) = (u32x4){pk2(acc[0] * rl, acc[1] * rl), pk2(acc[2] * rl, acc[3] * rl), pk2(acc[4] * rl, acc[5] * rl), pk2(acc[6] * rl, acc[7] * rl)};
            }
        }
        PH_END;
        if (PH_ON) PH_REP(4, layer == 0) {
            pg8::Gemm g{XN, (const bf16*)(wsq + WS_WOUT) + (size_t)layer * D * D, D, nullptr};
            pg8::StaticOrder S; S.init(NT, D, G, blk);
            pg8::EpiResN E{nullptr, (const bf16*)(wsq + WS_XB), nullptr, layer == 0 ? (bf16*)(wsq + WS_XR2) : (bf16*)xs, layer == 0 ? (float*)(wsq + WS_RSS) : nullptr, layer == 0 ? D : 2 * D};

#ifndef SKIP_RES
                pg8::gemm_phase<pg8::EpiResN, pg8::StaticOrder, false>(lds, g, S, E);
#endif

        }
        PH_END;
        if (layer == 1) {
        if (PH_ON) PH_REP(6, true) {
            const float* gf = args.in[2] + layer * D;
            {
                LAS float* wr_l = (LAS float*)(lds);
                LAS int* hist = (LAS int*)(lds + 32768);
                LAS float* wsum = (LAS float*)(lds + 32768 + 64);
                LAS float* gl_l = (LAS float*)(lds + 36864);
                { constexpr int TOT = NEXP * D * DFFE, STRIDE = 7151;
                  float sv[3][8];
#pragma unroll
                  for (int ts = 0; ts < 3; ++ts)
#pragma unroll
                      for (int q = 0; q < 8; ++q) asm volatile("global_load_dword %0, %1, off" : "=&v"(sv[ts][q]) : "v"(args.in[19 + ts] + (size_t)(tid * 8 + q) * STRIDE) : "memory");
                  static_assert((size_t)4095 * STRIDE < (size_t)TOT, "sample inside the tensor");
                  asm volatile("s_waitcnt vmcnt(0)" ::: "memory");
#pragma unroll
                  for (int ts = 0; ts < 3; ++ts) { float a = 0.f;
#pragma unroll
                      for (int q = 0; q < 8; ++q) { asm volatile("" : "+v"(sv[ts][q])); a += fabsf(sv[ts][q]); }
                      a = wave_sum(a); if (lane == 0) wsum[ts * 8 + wave] = a; } }
                { f32x4 wv[4];
#pragma unroll
                  for (int u = 0; u < 4; ++u) { const int i = tid + u * (NWAVES * 64), c = i >> 1, half = i & 1; wv[u] = *(const f32x4*)(args.in[18] + c * 8 + half * 4); }
                  if (tid < 256) *(LAS f32x4*)(gl_l + tid * 4) = *(const f32x4*)(gf + tid * 4);
#pragma unroll
                  for (int u = 0; u < 4; ++u) { const int i = tid + u * (NWAVES * 64), c = i >> 1, half = i & 1, ln = (c & 255) >> 2, q = c & 3, j = c >> 8;
                    *(LAS f32x4*)(wr_l + half * 4096 + ((j * 4 + q) * 64 + ln) * 4) = wv[u]; } }
                __syncthreads();
                float wscale[3];
#pragma unroll
                for (int ts = 0; ts < 3; ++ts) { float a = 0.f;
#pragma unroll
                    for (int w8 = 0; w8 < 8; ++w8) a += wsum[ts * 8 + w8];
                    const float sigma = a * (1.f / 4096.f) * 1.2533141f;
                    wscale[ts] = exp2f(rintf(log2f(8.f / fmaxf(sigma, 1e-30f)))); }
                if (blk == 0 && tid == 0) { SCAL[8] = 1.f / (8.f * wscale[0]); SCAL[9] = 1.f / (8.f * wscale[1]); SCAL[10] = 1.f / (8.f * wscale[2]); }
                unsigned char* XN8 = wsq + WS_XN8;
                LAS unsigned* scr = (LAS unsigned*)(lds + 40960 + wave * 4352);
                constexpr int I_G = 8 * 112, I_D = 28 * 32, PER_E = 2 * I_G + I_D, NIT = NEXP * PER_E;
                auto dec1 = [&](int it) -> CvtItem8 { CvtItem8 I; const int e = it / PER_E; int r = it % PER_E;
                    if (r < 2 * I_G) { const int up = r / I_G; r %= I_G; const int kb = r / 112, nb = r % 112;
                        I.src = args.in[19 + up] + (size_t)e * D * DFFE + (size_t)(128 * kb) * DFFE + 32 * nb; I.ldn = DFFE; I.dst = wsq + WS_WGUM + (size_t)e * 2 * DFFE * D + 128 * kb; I.Kd = D;
                        I.r0 = (nb >> 2) * 256 + up * 128 + (nb & 3) * 32; I.r1 = 0; I.scale = up ? wscale[1] : wscale[0]; return I; }
                    r -= 2 * I_G; const int kb = r / 32, nb = r % 32;
                    I.src = args.in[21] + (size_t)e * DFFE * D + (size_t)(128 * kb) * D + 32 * nb; I.ldn = D; I.dst = wsq + WS_WDNM + (size_t)e * D * DFFE + 128 * kb; I.Kd = DFFE; I.r0 = 32 * nb; I.r1 = 0; I.scale = wscale[2]; return I; };
                int cit = gw; bool pend = false; CvtItem8 Ic = dec1(0); f32x4 cr_[16];
#pragma unroll
                for (int z_ = 0; z_ < 16; ++z_) cr_[z_] = (f32x4){0.f, 0.f, 0.f, 0.f};
                for (int c = blk; c < 256; c += G) {
                    __syncthreads();
                    if (tid < 8) hist[tid] = 0;
                    __syncthreads();
                    u32x2 nx[4];
                    { const u32x2* xr = (const u32x2*)((const bf16*)xs + (size_t)(c * 128 + wave * 16) * (2 * D)) + lane;
#pragma unroll
                      for (int j = 0; j < 4; ++j) asm volatile("global_load_dwordx2 %0, %1, off" : "=&v"(nx[j]) : "v"(xr + 64 * j) : "memory");
                      asm volatile("s_waitcnt vmcnt(0)" ::: "memory"); }
                    int re0 = 0, re1 = 0; float rg0 = 0.f, rg1 = 0.f;
                    for (int k = 0; k < 16; ++k) {
                        if (pend) { CVT_TOUCH(cr_); cvt_proc8(cr_, Ic, scr, lane); pend = false; }
                        const int m = c * 128 + wave * 16 + k; f32x4 v[4];
#pragma unroll
                        for (int j = 0; j < 4; ++j) { asm volatile("" : "+v"(nx[j])); v[j] = (f32x4){bflo(nx[j].x), bfhi(nx[j].x), bflo(nx[j].y), bfhi(nx[j].y)}; }
                        { const u32x2* xr = (const u32x2*)((const bf16*)xs + (size_t)(k + 1 < 16 ? m + 1 : m) * (2 * D)) + lane;
#pragma unroll
                            for (int j = 0; j < 4; ++j) asm volatile("global_load_dwordx2 %0, %1, off" : "=&v"(nx[j]) : "v"(xr + 64 * j) : "memory"); }
                        if (cit < NIT) { Ic = dec1(cit); cvt_load4(cr_, Ic, lane); cit += NGW; pend = true; }
                        { float sq = 0.f;
#pragma unroll
                          for (int j = 0; j < 4; ++j) sq += (v[j][0] * v[j][0] + v[j][1] * v[j][1]) + (v[j][2] * v[j][2] + v[j][3] * v[j][3]);
                          const float r = 1.0f / sqrtf(wave_sum(sq) * (1.f / D) + EPS);
#pragma unroll
                          for (int j = 0; j < 4; ++j) { const f32x4 gg = *(const LAS f32x4*)(gl_l + (lane + 64 * j) * 4); v[j] = v[j] * r * gg;
                              *(unsigned*)(XN8 + (size_t)m * D + 4 * lane + 256 * j) = pg8::pk4_fp8(8.f * v[j][0], 8.f * v[j][1], 8.f * v[j][2], 8.f * v[j][3]); } }
                        float lg[8];
#pragma unroll
                        for (int e = 0; e < 8; ++e) lg[e] = 0.f;
#pragma unroll
                        for (int j = 0; j < 4; ++j)
#pragma unroll
                            for (int q = 0; q < 4; ++q) { const f32x4 w0 = *(const LAS f32x4*)(wr_l + ((j * 4 + q) * 64 + lane) * 4), w1 = *(const LAS f32x4*)(wr_l + 4096 + ((j * 4 + q) * 64 + lane) * 4); const float xv = v[j][q];
                                lg[0] += xv * w0[0]; lg[1] += xv * w0[1]; lg[2] += xv * w0[2]; lg[3] += xv * w0[3]; lg[4] += xv * w1[0]; lg[5] += xv * w1[1]; lg[6] += xv * w1[2]; lg[7] += xv * w1[3]; }
                        { const bool b5 = lane & 32, b4 = lane & 16, b3 = lane & 8; float a4[4], a2[2], a1;
#pragma unroll
                          for (int i = 0; i < 4; ++i) { const float keep = b5 ? lg[4 + i] : lg[i], send = b5 ? lg[i] : lg[4 + i]; a4[i] = keep + __shfl_xor(send, 32); }
#pragma unroll
                          for (int i = 0; i < 2; ++i) { const float keep = b4 ? a4[2 + i] : a4[i], send = b4 ? a4[i] : a4[2 + i]; a2[i] = keep + __shfl_xor(send, 16); }
                          { const float keep = b3 ? a2[1] : a2[0], send = b3 ? a2[0] : a2[1]; a1 = keep + __shfl_xor(send, 8); }
                          a1 += __shfl_xor(a1, 4); a1 += __shfl_xor(a1, 2); a1 += __shfl_xor(a1, 1);
#pragma unroll
                          for (int e = 0; e < 8; ++e) lg[e] = __int_as_float(__builtin_amdgcn_readlane(__float_as_int(a1), ((e >> 2) & 1) * 32 + ((e >> 1) & 1) * 16 + (e & 1) * 8)); }
                        int e0 = 0; float v0 = lg[0];
#pragma unroll
                        for (int e = 1; e < 8; ++e) if (lg[e] > v0) { v0 = lg[e]; e0 = e; }
                        int e1 = -1; float v1 = -INFINITY;
#pragma unroll
                        for (int e = 0; e < 8; ++e) if (e != e0 && lg[e] > v1) { v1 = lg[e]; e1 = e; }
                        { const float g1 = 1.f / (1.f + expf(v0 - v1)), g0 = 1.f - g1;
                          const bool mine = lane == k; re0 = mine ? e0 : re0; re1 = mine ? e1 : re1; rg0 = mine ? g0 : rg0; rg1 = mine ? g1 : rg1; }
                        asm volatile("s_waitcnt vmcnt(4)" ::: "memory");
                    }
                    if (pend) { CVT_TOUCH(cr_); cvt_proc8(cr_, Ic, scr, lane); pend = false; }
                    if (lane < 16) { const int m = c * 128 + wave * 16 + lane;
                        TOKE[2 * m] = re0; TOKE[2 * m + 1] = re1; TOKG[2 * m] = rg0; TOKG[2 * m + 1] = rg1;
                        atomicAdd((int*)&hist[re0], 1); atomicAdd((int*)&hist[re1], 1); }
                    __syncthreads();
                    if (tid < 8) HIST[c * 8 + tid] = hist[tid];
                }
                while (cit < NIT) { Ic = dec1(cit); cvt_load4(cr_, Ic, lane); cit += NGW; asm volatile("s_waitcnt vmcnt(0)" ::: "memory"); CVT_TOUCH(cr_); cvt_proc8(cr_, Ic, scr, lane); }
            }
        }
        PH_END;
        }
        if (layer == 0) {
            if (PH_ON) PH_REP(7, true) {
                pg8::Gemm g{(const bf16*)(wsq + WS_XR2), (const bf16*)(wsq + WS_WGUD), D, nullptr};
                pg8::StaticOrder S; S.init(NT, 2 * DFF, G, blk);
                pg8::EpiSwiGLU E{(bf16*)(wsq + WS_HID), DFF, 0, (const float*)(wsq + WS_RSS)};

#ifndef SKIP_GUD
                pg8::gemm_phase<pg8::EpiSwiGLU, pg8::StaticOrder, false>(lds, g, S, E);
#endif

            }
            PH_END;
            if (PH_ON) {
                pg8::Gemm g{(const bf16*)(wsq + WS_HID), (const bf16*)(wsq + WS_WDND), DFF, nullptr};
                pg8::StaticOrder S; S.init(NT, D, G, blk);
                pg8::EpiResN E{nullptr, (const bf16*)(wsq + WS_XR2), nullptr, (bf16*)(wsq + WS_XB), (float*)(wsq + WS_RSS), D};

#ifndef SKIP_RES
                pg8::gemm_phase<pg8::EpiResN, pg8::StaticOrder, false>(lds, g, S, E);
#endif

            }
            PH_END;
        } else {
            if (PH_ON) {
                LAS int* H = (LAS int*)lds;
                LAS int* tot = (LAS int*)(lds + 8192);
                LAS int* pre = (LAS int*)(lds + 8192 + 64);
                { int hv[4];
#pragma unroll
                  for (int u = 0; u < 4; ++u) hv[u] = HIST[tid + u * (NWAVES * 64)];
#pragma unroll
                  for (int u = 0; u < 4; ++u) H[tid + u * (NWAVES * 64)] = hv[u]; }
                __syncthreads();
                { const int e = wave;
                  const int h0 = H[(4 * lane) * 8 + e], h1 = H[(4 * lane + 1) * 8 + e], h2 = H[(4 * lane + 2) * 8 + e], h3 = H[(4 * lane + 3) * 8 + e];
                  const int s = h0 + h1 + h2 + h3; int inc = s;
#pragma unroll
                  for (int o = 1; o < 64; o <<= 1) { const int t = __shfl_up(inc, o); if (lane >= o) inc += t; }
                  const int ex = inc - s;
                  pre[(4 * lane) * 8 + e] = ex; pre[(4 * lane + 1) * 8 + e] = ex + h0; pre[(4 * lane + 2) * 8 + e] = ex + h0 + h1; pre[(4 * lane + 3) * 8 + e] = ex + h0 + h1 + h2;
                  if (lane == 63) tot[e] = inc; }
                __syncthreads();
                int tstart[8]; { int acc = 0;
#pragma unroll
                  for (int e = 0; e < 8; ++e) { tstart[e] = acc; acc += (tot[e] + 255) >> 8; }
                  if (blk == 0 && tid == 0) { int a2 = 0; for (int e = 0; e < 8; ++e) { a2 += (tot[e] + 255) >> 8; META[e] = a2; } META[8] = a2; } }
                if (wave == 0) {
                    for (int c = blk; c < 256; c += G) {
                        int run[8];
#pragma unroll
                        for (int e = 0; e < 8; ++e) run[e] = tstart[e] * 256 + pre[c * 8 + e];
                        int pev[4];
#pragma unroll
                        for (int rd = 0; rd < 4; ++rd) pev[rd] = TOKE[c * 256 + rd * 64 + lane];
#pragma unroll
                        for (int rd = 0; rd < 4; ++rd) {
                            const int p = c * 256 + rd * 64 + lane;
                            const int pe = pev[rd]; int slot = 0;
#pragma unroll
                            for (int e = 0; e < 8; ++e) { const unsigned long long mk = __ballot(pe == e);
                                if (pe == e) slot = run[e] + __popcll(mk & ((1ull << lane) - 1ull));
                                run[e] += __popcll(mk); }
                            ROWTOK[slot] = p >> 1; PSLOT[p] = slot;
                        }
                    }
                }
            }
            PH_END;
            int te[8]; int ntiles;
            for (int r = 0; r < NROUNDS; ++r) {
                if (PH_ON) PH_REP(10, true) {
                    { const int mv = __hip_atomic_load(META + (lane < 9 ? lane : 8), __ATOMIC_RELAXED, __HIP_MEMORY_SCOPE_AGENT);
#pragma unroll
                      for (int e = 0; e < 8; ++e) te[e] = __builtin_amdgcn_readlane(mv, e);
                      ntiles = __builtin_amdgcn_readlane(mv, 8); }
                    const int ntr = ntiles - r * RT < RT ? ntiles - r * RT : RT;
                    if (ntr > 0) {
                        pg8::Gemm g{(const bf16*)(wsq + WS_XN8), (const bf16*)(wsq + WS_WGUM), D / 2, ROWTOK};
                        pg8::MoeOrder S; S.so.init(ntr * 256, 2 * DFFE, G, blk); S.pm0 = r * RT;
#pragma unroll
                        for (int e = 0; e < 8; ++e) S.te[e] = te[e];
                        pg8::EpiSwiGLU8 E{wsq + WS_HIDM, DFFE, SCAL[8], SCAL[9]};
#ifndef SKIP_GUM
                        pg8::gemm_phase<pg8::EpiSwiGLU8, pg8::MoeOrder, true, true>(lds, g, S, E);
#endif

                    }
                }
                PH_END;
                if (PH_ON) PH_REP(11, true) {
                    { const int mv = __hip_atomic_load(META + (lane < 9 ? lane : 8), __ATOMIC_RELAXED, __HIP_MEMORY_SCOPE_AGENT);
#pragma unroll
                      for (int e = 0; e < 8; ++e) te[e] = __builtin_amdgcn_readlane(mv, e);
                      ntiles = __builtin_amdgcn_readlane(mv, 8); }
                    const int ntr = ntiles - r * RT < RT ? ntiles - r * RT : RT;
                    if (ntr > 0) {
                        pg8::Gemm g{(const bf16*)(wsq + WS_HIDM), (const bf16*)(wsq + WS_WDNM), DFFE / 2, nullptr};
                        pg8::MoeOrder S; S.so.init(ntr * 256, D, G, blk); S.pm0 = r * RT;
#pragma unroll
                        for (int e = 0; e < 8; ++e) S.te[e] = te[e];
                        pg8::EpiBfS E{(bf16*)(wsq + WS_YPAD), SCAL[10]};
#ifndef SKIP_DNM
                        pg8::gemm_phase<pg8::EpiBfS, pg8::MoeOrder, false, true>(lds, g, S, E);
#endif

                    }
                }
                PH_END;
            }
            if (PH_ON) {
                const bf16* Y = (const bf16*)(wsq + WS_YPAD);
                int t = gw;
                u32x2 hn[4], an[4], bn[4]; float g0n = 0.f, g1n = 0.f;
#pragma unroll
                for (int j = 0; j < 4; ++j) { hn[j] = (u32x2){0u, 0u}; an[j] = hn[j]; bn[j] = hn[j]; }
#define FIN_LOAD(tt) do { const int s0_ = PSLOT[2 * (tt)], s1_ = PSLOT[2 * (tt) + 1]; g0n = TOKG[2 * (tt)]; g1n = TOKG[2 * (tt) + 1]; \
                    const u32x2* h_ = (const u32x2*)((const bf16*)xs + (size_t)(tt) * (2 * D)) + lane; \
                    const u32x2* y0_ = (const u32x2*)(Y + (size_t)s0_ * D) + lane; const u32x2* y1_ = (const u32x2*)(Y + (size_t)s1_ * D) + lane; \
                    _Pragma("unroll") for (int j = 0; j < 4; ++j) { hn[j] = h_[64 * j]; an[j] = y0_[64 * j]; bn[j] = y1_[64 * j]; } } while (0)
                if (t < NT) FIN_LOAD(t);
                while (t < NT) {
                    u32x2 hc[4], ac[4], bc[4]; const float g0 = g0n, g1 = g1n;
#pragma unroll
                    for (int j = 0; j < 4; ++j) { hc[j] = hn[j]; ac[j] = an[j]; bc[j] = bn[j]; }
                    const int t2 = t + NGW;
                    if (t2 < NT) FIN_LOAD(t2);
                    f32x4* xr = (f32x4*)(xs + (size_t)t * D) + lane;
#pragma unroll
                    for (int j = 0; j < 4; ++j) { f32x4 v;
                        v[0] = bflo(hc[j].x) + (g0 * bflo(ac[j].x) + g1 * bflo(bc[j].x)); v[1] = bfhi(hc[j].x) + (g0 * bfhi(ac[j].x) + g1 * bfhi(bc[j].x));
                        v[2] = bflo(hc[j].y) + (g0 * bflo(ac[j].y) + g1 * bflo(bc[j].y)); v[3] = bfhi(hc[j].y) + (g0 * bfhi(ac[j].y) + g1 * bfhi(bc[j].y));
                        xr[64 * j] = v; }
                    t = t2;
                }
#undef FIN_LOAD
            }
            PH_END;
        }
    }
#undef XN
#undef QKV
#undef PARTA
#undef PARTB
#undef LA
#undef LB
#undef RLUT
#undef SCAL
#undef HIST
#undef META
#undef TOKE
#undef TOKG
#undef PSLOT
#undef ROWTOK
#undef PH_ON
#undef PH_END
}

#ifndef MK_MULTI
#define MK_MULTI 0
#endif
extern "C" void kernel_launch(void* const* d_in, const int* in_sizes, int n_in, void* d_out, int out_size, void* d_ws, size_t ws_size, hipStream_t stream) {
    static int grid = 0;
    if (grid == 0) {
        if (n_in != 22 || out_size != NT * D || ws_size < WS_END) { fprintf(stderr, "kernel_launch: unexpected shapes (n_in %d, out %d, ws %zu)\n", n_in, out_size, ws_size); grid = -1; return; }
        int dev = 0, cus = 0, per_cu = 0;
        if (hipGetDevice(&dev) != hipSuccess || hipDeviceGetAttribute(&cus, hipDeviceAttributeMultiprocessorCount, dev) != hipSuccess) { grid = -1; return; }
        if (hipFuncSetAttribute((const void*)fwd_kernel, hipFuncAttributeMaxDynamicSharedMemorySize, LDS_BYTES) != hipSuccess) { fprintf(stderr, "kernel_launch: hipFuncSetAttribute failed\n"); grid = -1; return; }
        if (hipOccupancyMaxActiveBlocksPerMultiprocessor(&per_cu, (const void*)fwd_kernel, NWAVES * 64, LDS_BYTES) != hipSuccess || per_cu < 1) fprintf(stderr, "kernel_launch: occupancy query reports %d\n", per_cu);
        (void)hipGetLastError();
        grid = cus;
    }
    if (grid < 0) return;
    if (hipMemsetAsync((char*)d_ws + WS_CTL, 0, CTL_ZERO_BYTES, stream) != hipSuccess) return;
    Args a{};
    for (int i = 0; i < 22; ++i) a.in[i] = (const float*)d_in[i];
    a.out = (float*)d_out; a.ws = (unsigned char*)d_ws;
    constexpr int NPH = 1 + 6 + 5 + 1 + 2 * NROUNDS + 1;
#if MK_MULTI
    for (int p = 0; p < NPH; ++p) { a.ph_lo = p; a.ph_hi = p + 1; hipLaunchKernelGGL(fwd_kernel, dim3(grid), dim3(NWAVES * 64), LDS_BYTES, stream, a); }
#else
    a.ph_lo = 0; a.ph_hi = NPH + 1;
    hipLaunchKernelGGL(fwd_kernel, dim3(grid), dim3(NWAVES * 64), LDS_BYTES, stream, a);
#endif
    const hipError_t le = hipPeekAtLastError();
    if (le != hipSuccess) fprintf(stderr, "kernel_launch: launch failed: %s\n", hipGetErrorName(le));
}
```

```cpp
#include <hip/hip_runtime.h>
#include <cstdio>
#include <cstdint>

#define GAS __attribute__((address_space(1)))
#define LAS __attribute__((address_space(3)))
typedef unsigned short bf16;
typedef short bf16x8 __attribute__((ext_vector_type(8)));
typedef short s16x4 __attribute__((ext_vector_type(4)));
typedef float f32x4 __attribute__((ext_vector_type(4)));
typedef float f32x2 __attribute__((ext_vector_type(2)));
typedef float f32x16 __attribute__((ext_vector_type(16)));
typedef unsigned u32x4 __attribute__((ext_vector_type(4)));
typedef unsigned u32x2 __attribute__((ext_vector_type(2)));
typedef GAS unsigned gu32;
typedef int v4i __attribute__((ext_vector_type(4)));
typedef int v8i __attribute__((ext_vector_type(8)));

constexpr int NB = 16, SEQ = 2048, NT = NB * SEQ, D = 1024;
constexpr int PROJ = 3072, DFF = 2816, DFFE = 3584, NEXP = 8;
constexpr int NGRP = 48;
constexpr float EPS = 1e-6f;
constexpr float LOG2E = 1.4426950408889634f;
constexpr float C2 = 0.125f * LOG2E;
constexpr int MAXTILES = 264;
constexpr int RT = MAXTILES;
constexpr int NROUNDS = 1;

constexpr size_t MiB = 1u << 20;
constexpr size_t WS_CTL = 0, CTL_ZERO_BYTES = 64 * 1024;
constexpr size_t WS_LUT = 1 * MiB;
constexpr size_t WS_SCAL = WS_LUT + 64 * 1024;
constexpr size_t WS_HIST = WS_SCAL + 4096;
constexpr size_t WS_META = WS_HIST + 16384;
constexpr size_t WS_TOKE = 2 * MiB;
constexpr size_t WS_TOKG = WS_TOKE + 256 * 1024;
constexpr size_t WS_PSLOT = WS_TOKG + 256 * 1024;
constexpr size_t WS_ROWTOK = WS_PSLOT + 256 * 1024;
constexpr size_t WS_WIN = 4 * MiB;
constexpr size_t WS_WOUT = 16 * MiB;
constexpr size_t WS_WGUD = 20 * MiB;
constexpr size_t WS_WDND = 31 * MiB;
constexpr size_t WS_XN = 40 * MiB;
constexpr size_t WS_QKV = 104 * MiB;
constexpr size_t WS_PARTA = 296 * MiB;
constexpr size_t WS_PARTB = 392 * MiB;
constexpr size_t WS_LA = 456 * MiB;
constexpr size_t WS_LB = 459 * MiB;
constexpr size_t WS_RSS = 37 * MiB;
constexpr size_t WS_XR2 = 104 * MiB;
constexpr size_t WS_XB = 392 * MiB;
constexpr size_t WS_HID = 168 * MiB;
constexpr size_t WS_XN8 = 4 * MiB;
constexpr size_t WS_WGUM = 36 * MiB;
constexpr size_t WS_WDNM = 92 * MiB;
constexpr size_t WS_HIDM = 120 * MiB;
constexpr size_t WS_YPAD = 352 * MiB;
constexpr size_t WS_END = 484 * MiB;
constexpr int CW_BAR = 1024;

constexpr int RING_BYTES = 131072;
constexpr int LDSCTL_OFF = RING_BYTES, MISC_OFF = LDSCTL_OFF + 320;
constexpr int LDS_BYTES = 147456;
constexpr int NWAVES = 8;

__device__ __forceinline__ unsigned f2bf(float f) { unsigned u = __builtin_bit_cast(unsigned, f); return (u + 0x7fffu + ((u >> 16) & 1u)) >> 16; }
__device__ __forceinline__ unsigned pk2(float lo, float hi) { return f2bf(lo) | (f2bf(hi) << 16); }
__device__ __forceinline__ float bf2f(unsigned short h) { return __builtin_bit_cast(float, (unsigned)h << 16); }
__device__ __forceinline__ float bflo(unsigned w) { return __builtin_bit_cast(float, w << 16); }
__device__ __forceinline__ float bfhi(unsigned w) { return __builtin_bit_cast(float, w & 0xffff0000u); }
typedef __bf16 bf16x2_t __attribute__((ext_vector_type(2)));
__device__ __forceinline__ unsigned cvt_pk_bf16(float lo, float hi) { const f32x2 v = {lo, hi}; return __builtin_bit_cast(unsigned, __builtin_convertvector(v, bf16x2_t)); }
__device__ __forceinline__ float wave_sum(float v) {
#pragma unroll
    for (int o = 1; o < 64; o <<= 1) v += __shfl_xor(v, o);
    return v;
}
__device__ __forceinline__ unsigned char* opq_p(unsigned char* p) { int z = 0; asm volatile("" : "+v"(z)); return p + (unsigned)__builtin_amdgcn_readfirstlane(z); }
__device__ __forceinline__ int opq(int v) { asm volatile("" : "+v"(v)); return v; }
#define LDS_WAIT() asm volatile("s_waitcnt lgkmcnt(0)" ::: "memory")
#define VM_WAIT() asm volatile("s_waitcnt vmcnt(0)" ::: "memory")

__device__ __forceinline__ int t5_bucket(int n) {
    if (n < 16) return n;
    return 16 + (n >= 19) + (n >= 21) + (n >= 24) + (n >= 27) + (n >= 31) + (n >= 35) + (n >= 40) + (n >= 46) + (n >= 52) + (n >= 59) + (n >= 67) + (n >= 77) + (n >= 87) + (n >= 99) + (n >= 113);
}

namespace pg8 {
constexpr int BM = 256, BK = 64, HALF = 128, HTB = HALF * BK * 2, STAGE_BYTES = 8 * HTB, NXCD = 8, WGM = 8;
__host__ __device__ __forceinline__ int lds_byte(int r, int c) { const int st = (r >> 4) * 2 + (c >> 5), rr = r & 15, cc = c & 31, ob = rr * 64 + cc * 2; return st * 1024 + (ob ^ (((ob >> 9) & 1) << 5)); }
__host__ __device__ __forceinline__ void stage_rc(int b, int& R, int& C) { const int st = b / 1024, sb = b % 1024, swz = sb ^ (((sb >> 9) & 1) << 5); R = (st >> 1) * 16 + swz / 64; C = (st & 1) * 32 + (swz % 64) / 2; }
__host__ __device__ __forceinline__ int perm32(int rho) { const int n = rho >> 4, i = rho & 15; return 8 * (i >> 2) + 4 * n + (i & 3); }

struct Unit { int pm, pn, pb, pa; };
struct Gemm { const bf16* A; const bf16* Bt; int K; const int* rowmap; };

struct StaticOrder {
    int nM, nN, nwg, G, c;
    __device__ void init(int M, int N, int G_, int c_) { nM = M / BM; nN = N / BM; nwg = nM * nN; G = G_; c = c_; }
    __device__ bool next(int i, Unit& u) const {
        const long L = (long)i * G + c; if (L >= nwg) return false;
        int wgid = (int)L; { const int q = nwg / NXCD, r = nwg % NXCD, xcd = wgid % NXCD, off = wgid / NXCD; wgid = (xcd < r ? xcd * (q + 1) : r * (q + 1) + (xcd - r) * q) + off; }
        const int nig = WGM * nN, gid = wgid / nig, fm = gid * WGM, gsz = (nM - fm) < WGM ? (nM - fm) : WGM;
        u.pm = fm + ((wgid % nig) % gsz); u.pn = (wgid % nig) / gsz; u.pb = u.pn; u.pa = u.pm; return true;
    }
};
struct MoeOrder {
    StaticOrder so; int pm0; int te[8];
    __device__ bool next(int i, Unit& u) const {
        if (!so.next(i, u)) return false;
        u.pa = u.pm; u.pm += pm0;
        int e = 0;
#pragma unroll
        for (int k = 0; k < 7; ++k) e += (u.pm >= te[k]) ? 1 : 0;
        u.pb = e * so.nN + u.pn; return true;
    }
};

__device__ __forceinline__ float row_rnorm(const float* rss, int row) {
    if (!rss) return 1.f;
    const f32x4* p = (const f32x4*)(rss + (size_t)row * 16); const f32x4 a = p[0], b = p[1], c = p[2], d = p[3];
    const float t = ((a[0] + a[1]) + (a[2] + a[3])) + ((b[0] + b[1]) + (b[2] + b[3])) + (((c[0] + c[1]) + (c[2] + c[3])) + ((d[0] + d[1]) + (d[2] + d[3])));
    return __builtin_amdgcn_rsqf(t * (1.f / D) + EPS);
}
__device__ __forceinline__ void rn_load(f32x4 (&r)[4], const float* rss, int row) {
    if (!rss) return;
    const f32x4* p = (const f32x4*)(rss + (size_t)row * 16); r[0] = p[0]; r[1] = p[1]; r[2] = p[2]; r[3] = p[3];
}
__device__ __forceinline__ float rn_finish(const f32x4 (&r)[4], const float* rss) {
    if (!rss) return 1.f;
    const f32x4 a = r[0], b = r[1], c = r[2], d = r[3];
    const float t = ((a[0] + a[1]) + (a[2] + a[3])) + ((b[0] + b[1]) + (b[2] + b[3])) + (((c[0] + c[1]) + (c[2] + c[3])) + ((d[0] + d[1]) + (d[2] + d[3])));
    return __builtin_amdgcn_rsqf(t * (1.f / D) + EPS);
}
__device__ __forceinline__ void rn_all(float (&rrv)[8], const float* rss, int row0, int fq) {
    if (!rss) {
#pragma unroll
        for (int g = 0; g < 8; ++g) rrv[g] = 1.f;
        return; }
    f32x4 q[8];
#pragma unroll
    for (int g = 0; g < 8; ++g) q[g] = *(const f32x4*)(rss + (size_t)(row0 + (g >> 2) * HALF + (g & 3) * 16) * 16 + 4 * fq);
    float t8[8];
#pragma unroll
    for (int g = 0; g < 8; ++g) rrv[g] = (q[g][0] + q[g][1]) + (q[g][2] + q[g][3]);
#pragma unroll
    for (int g = 0; g < 8; ++g) t8[g] = __shfl_xor(rrv[g], 16);
#pragma unroll
    for (int g = 0; g < 8; ++g) rrv[g] += t8[g];
#pragma unroll
    for (int g = 0; g < 8; ++g) t8[g] = __shfl_xor(rrv[g], 32);
#pragma unroll
    for (int g = 0; g < 8; ++g) rrv[g] = __builtin_amdgcn_rsqf((rrv[g] + t8[g]) * (1.f / D) + EPS);
}
struct EpiQKV {
    bf16* QKV; const float* gn[4]; const float* rss;
    __device__ __forceinline__ void operator()(const f32x4 (&acc)[2][2][4][2], const Unit& u, int wr, int wc, int fr, int fq) const {
        const int G = u.pn * 4 + wc, kind = G >> 3;
        const float* gp = kind == 0 ? gn[0] : kind == 1 ? gn[1] : kind == 3 ? gn[2] : kind == 4 ? gn[3] : nullptr;
        const float qs = (kind == 0 || kind == 3) ? C2 : 1.f;
        f32x4 gv[2][2];
#pragma unroll
        for (int bj = 0; bj < 2; ++bj)
#pragma unroll
            for (int n = 0; n < 2; ++n) gv[bj][n] = gp ? *(const f32x4*)(gp + 32 * bj + 8 * fq + 4 * n) * qs : (f32x4){1.f, 1.f, 1.f, 1.f};
        bf16* base = QKV + (size_t)G * NT * 64 + 8 * fq;
        float rrv[8]; rn_all(rrv, rss, u.pm * BM + wr * 64 + fr, fq);
        float ssv[8];
#pragma unroll
        for (int g8 = 0; g8 < 8; ++g8) { float ss = 0.f;
#pragma unroll
            for (int bj = 0; bj < 2; ++bj)
#pragma unroll
                for (int n = 0; n < 2; ++n) { const f32x4 v = acc[g8 >> 2][bj][g8 & 3][n]; ss += (v[0] * v[0] + v[1] * v[1]) + (v[2] * v[2] + v[3] * v[3]); }
            ssv[g8] = ss; }
        if (gp) {
            float t8[8];
#pragma unroll
            for (int g8 = 0; g8 < 8; ++g8) t8[g8] = __shfl_xor(ssv[g8], 16);
#pragma unroll
            for (int g8 = 0; g8 < 8; ++g8) ssv[g8] += t8[g8];
#pragma unroll
            for (int g8 = 0; g8 < 8; ++g8) t8[g8] = __shfl_xor(ssv[g8], 32);
#pragma unroll
            for (int g8 = 0; g8 < 8; ++g8) ssv[g8] += t8[g8];
        }
#pragma unroll
        for (int ai = 0; ai < 2; ++ai)
#pragma unroll
            for (int m = 0; m < 4; ++m) {
                const int row = u.pm * BM + ai * HALF + wr * 64 + m * 16 + fr;
                const float rr = rrv[ai * 4 + m];
                const float ss = ssv[ai * 4 + m];
                const float r = (gp ? __builtin_amdgcn_rsqf(ss * (rr * rr) * (1.f / 64.f) + EPS) : 1.f) * rr;
#pragma unroll
                for (int bj = 0; bj < 2; ++bj) {
                    const f32x4 v0 = acc[ai][bj][m][0] * gv[bj][0] * r, v1 = acc[ai][bj][m][1] * gv[bj][1] * r;
                    u32x4 w; w.x = cvt_pk_bf16(v0[0], v0[1]); w.y = cvt_pk_bf16(v0[2], v0[3]); w.z = cvt_pk_bf16(v1[0], v1[1]); w.w = cvt_pk_bf16(v1[2], v1[3]);
                    *(u32x4*)(base + (size_t)row * 64 + 32 * bj) = w;
                }
            }
    }
};
struct EpiRes {
    const float* res; float* out;
    __device__ __forceinline__ void operator()(const f32x4 (&acc)[2][2][4][2], const Unit& u, int wr, int wc, int fr, int fq) const {
        const int col0 = u.pn * BM + wc * 32 + 8 * fq;
#pragma unroll
        for (int ai = 0; ai < 2; ++ai)
#pragma unroll
            for (int m = 0; m < 4; ++m) {
                const size_t ro = (size_t)(u.pm * BM + ai * HALF + wr * 64 + m * 16 + fr) * D + col0;
#pragma unroll
                for (int bj = 0; bj < 2; ++bj) {
                    const f32x4 r0 = *(const f32x4*)(res + ro + bj * HALF), r1 = *(const f32x4*)(res + ro + bj * HALF + 4);
                    *(f32x4*)(out + ro + bj * HALF) = r0 + acc[ai][bj][m][0];
                    *(f32x4*)(out + ro + bj * HALF + 4) = r1 + acc[ai][bj][m][1];
                }
            }
    }
};
struct EpiResN {
    const float* res32; const bf16* res16; float* out32; bf16* out16; float* rss; int ld16;
    __device__ __forceinline__ void operator()(const f32x4 (&acc)[2][2][4][2], const Unit& u, int wr, int wc, int fr, int fq) const {
        const int col0 = u.pn * BM + wc * 32 + 8 * fq;
#pragma unroll
        for (int ai = 0; ai < 2; ++ai) {
            u32x4 rwv[4][2];
            if (!res32) {
#pragma unroll
                for (int m = 0; m < 4; ++m)
#pragma unroll
                    for (int bj = 0; bj < 2; ++bj) rwv[m][bj] = *(const u32x4*)(res16 + (size_t)(u.pm * BM + ai * HALF + wr * 64 + m * 16 + fr) * D + col0 + bj * HALF);
            }
            float ssv[4];
#pragma unroll
            for (int m = 0; m < 4; ++m) {
                const int row = u.pm * BM + ai * HALF + wr * 64 + m * 16 + fr;
                const size_t ro = (size_t)row * D + col0; float ss = 0.f;
#pragma unroll
                for (int bj = 0; bj < 2; ++bj) {
                    f32x4 r0, r1;
                    if (res32) { r0 = *(const f32x4*)(res32 + ro + bj * HALF); r1 = *(const f32x4*)(res32 + ro + bj * HALF + 4); }
                    else { const u32x4 rw = rwv[m][bj]; r0 = (f32x4){bflo(rw.x), bfhi(rw.x), bflo(rw.y), bfhi(rw.y)}; r1 = (f32x4){bflo(rw.z), bfhi(rw.z), bflo(rw.w), bfhi(rw.w)}; }
                    const f32x4 v0 = r0 + acc[ai][bj][m][0], v1 = r1 + acc[ai][bj][m][1];
                    if (out32) { *(f32x4*)(out32 + ro + bj * HALF) = v0; *(f32x4*)(out32 + ro + bj * HALF + 4) = v1; }
                    if (out16) { u32x4 w; w.x = cvt_pk_bf16(v0[0], v0[1]); w.y = cvt_pk_bf16(v0[2], v0[3]); w.z = cvt_pk_bf16(v1[0], v1[1]); w.w = cvt_pk_bf16(v1[2], v1[3]);
                        *(u32x4*)(out16 + (size_t)row * ld16 + col0 + bj * HALF) = w;
                        ss += ((v0[0] * v0[0] + v0[1] * v0[1]) + (v0[2] * v0[2] + v0[3] * v0[3])) + ((v1[0] * v1[0] + v1[1] * v1[1]) + (v1[2] * v1[2] + v1[3] * v1[3])); }
                }
                ssv[m] = ss;
                __builtin_amdgcn_sched_barrier(0);
            }
            if (out16 && rss) { float t4[4];
#pragma unroll
                for (int m = 0; m < 4; ++m) t4[m] = __shfl_xor(ssv[m], 16);
#pragma unroll
                for (int m = 0; m < 4; ++m) ssv[m] += t4[m];
#pragma unroll
                for (int m = 0; m < 4; ++m) t4[m] = __shfl_xor(ssv[m], 32);
#pragma unroll
                for (int m = 0; m < 4; ++m) { ssv[m] += t4[m]; if (fq == 0) rss[(size_t)(u.pm * BM + ai * HALF + wr * 64 + m * 16 + fr) * 16 + u.pn * 4 + wc] = ssv[m]; }
            }
        }
    }
};
__device__ __forceinline__ float silu_mul(float g, float u) { return g * __builtin_amdgcn_rcpf(1.f + __builtin_amdgcn_exp2f(-g * LOG2E)) * u; }
__device__ __forceinline__ f32x4 silu_mul4(f32x4 g, f32x4 u) {
    const f32x4 t = g * (-LOG2E); f32x4 e; e[0] = __builtin_amdgcn_exp2f(t[0]); e[1] = __builtin_amdgcn_exp2f(t[1]); e[2] = __builtin_amdgcn_exp2f(t[2]); e[3] = __builtin_amdgcn_exp2f(t[3]);
    const f32x4 d = e + 1.f; f32x4 r; r[0] = __builtin_amdgcn_rcpf(d[0]); r[1] = __builtin_amdgcn_rcpf(d[1]); r[2] = __builtin_amdgcn_rcpf(d[2]); r[3] = __builtin_amdgcn_rcpf(d[3]);
    return (g * u) * r; }
struct EpiSwiGLU {
    bf16* H; int ldc; int pm0; const float* rss;
    __device__ __forceinline__ void operator()(const f32x4 (&acc)[2][2][4][2], const Unit& u, int wr, int wc, int fr, int fq) const {
        const int col0 = u.pn * HALF + wc * 32 + 8 * fq;
        float rrv[8]; rn_all(rrv, rss, (u.pm - pm0) * BM + wr * 64 + fr, fq);
#pragma unroll
        for (int ai = 0; ai < 2; ++ai)
#pragma unroll
            for (int m = 0; m < 4; ++m) {
                const int row = (u.pm - pm0) * BM + ai * HALF + wr * 64 + m * 16 + fr;
                const float rr = rrv[ai * 4 + m];
                const f32x4 g0 = acc[ai][0][m][0] * rr, g1 = acc[ai][0][m][1] * rr, u0 = acc[ai][1][m][0] * rr, u1 = acc[ai][1][m][1] * rr;
                u32x4 w;
                const f32x4 h0 = silu_mul4(g0, u0), h1 = silu_mul4(g1, u1);
                w.x = cvt_pk_bf16(h0[0], h0[1]); w.y = cvt_pk_bf16(h0[2], h0[3]); w.z = cvt_pk_bf16(h1[0], h1[1]); w.w = cvt_pk_bf16(h1[2], h1[3]);
                *(u32x4*)(H + (size_t)row * ldc + col0) = w;
            }
    }
};
struct EpiBf {
    bf16* O;
    __device__ __forceinline__ void operator()(const f32x4 (&acc)[2][2][4][2], const Unit& u, int wr, int wc, int fr, int fq) const {
        const int col0 = u.pn * BM + wc * 32 + 8 * fq;
#pragma unroll
        for (int ai = 0; ai < 2; ++ai)
#pragma unroll
            for (int m = 0; m < 4; ++m) {
                bf16* rowp = O + (size_t)(u.pm * BM + ai * HALF + wr * 64 + m * 16 + fr) * D + col0;
#pragma unroll
                for (int bj = 0; bj < 2; ++bj) { const f32x4 v0 = acc[ai][bj][m][0], v1 = acc[ai][bj][m][1];
                    u32x4 w; w.x = cvt_pk_bf16(v0[0], v0[1]); w.y = cvt_pk_bf16(v0[2], v0[3]); w.z = cvt_pk_bf16(v1[0], v1[1]); w.w = cvt_pk_bf16(v1[2], v1[3]);
                    *(u32x4*)(rowp + bj * HALF) = w; }
            }
    }
};

__device__ __forceinline__ float clamp448(float v) { return __builtin_amdgcn_fmed3f(v, -448.f, 448.f); }
__device__ __forceinline__ unsigned pk4_fp8(float a, float b, float c, float d) {
    int w = 0; w = __builtin_amdgcn_cvt_pk_fp8_f32(clamp448(a), clamp448(b), w, false); w = __builtin_amdgcn_cvt_pk_fp8_f32(clamp448(c), clamp448(d), w, true); return (unsigned)w; }
struct EpiSwiGLU8 {
    unsigned char* H; int ldc; float sg, su;
    __device__ __forceinline__ void operator()(const f32x4 (&acc)[2][2][4][2], const Unit& u, int wr, int wc, int fr, int fq) const {
        const int col0 = u.pn * HALF + wc * 32 + 8 * fq; const float su8 = su * 8.f;
        const float cg = -sg * LOG2E, kk = sg * su8, ik = 1.f / kk, lk = __builtin_amdgcn_logf(kk);
#pragma unroll
        for (int ai = 0; ai < 2; ++ai)
#pragma unroll
            for (int m = 0; m < 4; ++m) {
                const int row = u.pm * BM + ai * HALF + wr * 64 + m * 16 + fr;
                u32x2 w;
                f32x4 h0, h1;
                { const f32x4 ag = acc[ai][0][m][0], au = acc[ai][1][m][0]; const f32x4 t = ag * cg - lk; f32x4 e, r;
                  e[0] = __builtin_amdgcn_exp2f(t[0]); e[1] = __builtin_amdgcn_exp2f(t[1]); e[2] = __builtin_amdgcn_exp2f(t[2]); e[3] = __builtin_amdgcn_exp2f(t[3]);
                  const f32x4 d = e + ik; r[0] = __builtin_amdgcn_rcpf(d[0]); r[1] = __builtin_amdgcn_rcpf(d[1]); r[2] = __builtin_amdgcn_rcpf(d[2]); r[3] = __builtin_amdgcn_rcpf(d[3]);
                  h0 = (ag * au) * r; }
                { const f32x4 ag = acc[ai][0][m][1], au = acc[ai][1][m][1]; const f32x4 t = ag * cg - lk; f32x4 e, r;
                  e[0] = __builtin_amdgcn_exp2f(t[0]); e[1] = __builtin_amdgcn_exp2f(t[1]); e[2] = __builtin_amdgcn_exp2f(t[2]); e[3] = __builtin_amdgcn_exp2f(t[3]);
                  const f32x4 d = e + ik; r[0] = __builtin_amdgcn_rcpf(d[0]); r[1] = __builtin_amdgcn_rcpf(d[1]); r[2] = __builtin_amdgcn_rcpf(d[2]); r[3] = __builtin_amdgcn_rcpf(d[3]);
                  h1 = (ag * au) * r; }
                w.x = pk4_fp8(h0[0], h0[1], h0[2], h0[3]); w.y = pk4_fp8(h1[0], h1[1], h1[2], h1[3]);
                *(u32x2*)(H + (size_t)row * ldc + col0) = w;
                __builtin_amdgcn_sched_barrier(0);
            }
    }
};
struct EpiBfS {
    bf16* O; float s;
    __device__ __forceinline__ void operator()(const f32x4 (&acc)[2][2][4][2], const Unit& u, int wr, int wc, int fr, int fq) const {
        const int col0 = u.pn * BM + wc * 32 + 8 * fq;
#pragma unroll
        for (int ai = 0; ai < 2; ++ai)
#pragma unroll
            for (int m = 0; m < 4; ++m) {
                bf16* rowp = O + (size_t)(u.pm * BM + ai * HALF + wr * 64 + m * 16 + fr) * D + col0;
#pragma unroll
                for (int bj = 0; bj < 2; ++bj) { const f32x4 v0 = acc[ai][bj][m][0] * s, v1 = acc[ai][bj][m][1] * s;
                    u32x4 w; w.x = cvt_pk_bf16(v0[0], v0[1]); w.y = cvt_pk_bf16(v0[2], v0[3]); w.z = cvt_pk_bf16(v1[0], v1[1]); w.w = cvt_pk_bf16(v1[2], v1[3]);
                    *(u32x4*)(rowp + bj * HALF) = w; }
            }
    }
};

template <class Epi, class Sched, bool GATHER, bool FP8 = false>
__device__ __forceinline__ void gemm_phase(LAS unsigned char* lds, const Gemm g, const Sched& S, const Epi& E) {
    const int tid = opq(threadIdx.x), wid = __builtin_amdgcn_readfirstlane(tid >> 6), lane = tid & 63, wr = wid >> 2, wc = wid & 3, fr = lane & 15, fq = lane >> 4;
    const int K = g.K; int nt = K / BK; asm volatile("" : "+s"(nt));
    unsigned voffB[2], colA[2]; int RA[2];
#pragma unroll
    for (int i = 0; i < 2; ++i) { int R, C; stage_rc(tid * 16 + i * 8192, R, C); const int Rb = (R & ~31) + perm32(R & 31);
        RA[i] = R; colA[i] = (unsigned)C * 2u; voffB[i] = (unsigned)(Rb * K + C) * 2u; }
    const size_t kstep = (size_t)(BK * 2);
    const size_t hstep = (size_t)HALF * K * 2;
    const size_t tstep = 2 * hstep;
    const unsigned ldsw = (unsigned)wid * 1024u;
    const int aoff = lds_byte(wr * 64 + fr, fq * 8), boff = lds_byte(wc * 32 + fr, fq * 8);
#define PG8_SA(b, h) (((b) * 2 + (h)) * HTB)
#define PG8_SB(b, h) ((4 + (b) * 2 + (h)) * HTB)
#define PG8_STAGE(bufoff, gbase, voff) do { _Pragma("unroll") for (int _i = 0; _i < 2; ++_i) \
        __builtin_amdgcn_global_load_lds((const unsigned*)((const char*)(gbase) + (voff)[_i]), (LAS unsigned*)(lds + (bufoff) + ldsw + _i * 8192), 16, 0, 0); } while (0)
#define PG8_LDA(dst, b, h) do { _Pragma("unroll") for (int m = 0; m < 4; ++m) _Pragma("unroll") for (int k = 0; k < 2; ++k) dst[m][k] = *(const LAS bf16x8*)(lds + PG8_SA(b, h) + aoff + m * 2048 + k * 1024); } while (0)
#define PG8_LDB(dst, b, h) do { _Pragma("unroll") for (int n = 0; n < 2; ++n) _Pragma("unroll") for (int k = 0; k < 2; ++k) dst[n][k] = *(const LAS bf16x8*)(lds + PG8_SB(b, h) + boff + n * 2048 + k * 1024); } while (0)
#define PG8_MMA(ai, bj, At, Bt) do { __builtin_amdgcn_s_setprio(1); _Pragma("unroll") for (int m = 0; m < 4; ++m) _Pragma("unroll") for (int n = 0; n < 2; ++n) { \
        if constexpr (FP8) { const v4i b0_ = __builtin_bit_cast(v4i, Bt[n][0]), b1_ = __builtin_bit_cast(v4i, Bt[n][1]), a0_ = __builtin_bit_cast(v4i, At[m][0]), a1_ = __builtin_bit_cast(v4i, At[m][1]); \
            const v8i bb_ = __builtin_shufflevector(b0_, b1_, 0, 1, 2, 3, 4, 5, 6, 7), aa_ = __builtin_shufflevector(a0_, a1_, 0, 1, 2, 3, 4, 5, 6, 7); \
            asm volatile("v_mfma_f32_16x16x128_f8f6f4 %0, %1, %2, %0" : "+v"(acc[ai][bj][m][n]) : "v"(bb_), "v"(aa_)); } \
        else { _Pragma("unroll") for (int k = 0; k < 2; ++k) acc[ai][bj][m][n] = __builtin_amdgcn_mfma_f32_16x16x32_bf16(Bt[n][k], At[m][k], acc[ai][bj][m][n], 0, 0, 0); } } \
        __builtin_amdgcn_s_setprio(0); } while (0)
#define PG8_WAIT_V(n) asm volatile("s_waitcnt vmcnt(" #n ")" ::: "memory")
#define PG8_WAIT_L(n) asm volatile("s_waitcnt lgkmcnt(" #n ")" ::: "memory")
#define PG8_BAR __builtin_amdgcn_s_barrier()
#define PG8_SCHED __builtin_amdgcn_sched_barrier(0)
#define PG8_MKOFF(O, U) do { _Pragma("unroll") for (int _h = 0; _h < 2; ++_h) _Pragma("unroll") for (int _i = 0; _i < 2; ++_i) { \
        if constexpr (GATHER) O[_h][_i] = (unsigned)g.rowmap[(U).pm * BM + _h * HALF + RA[_i]] * (unsigned)(K * 2) + colA[_i]; \
        else O[_h][_i] = (unsigned)((_h * HALF + RA[_i]) * K) * 2u + colA[_i]; } } while (0)
    Unit cur, nxt; int ui = 0;
    if (!S.next(0, cur)) return;
    f32x4 acc[2][2][4][2];
#pragma unroll
    for (int a = 0; a < 2; ++a)
#pragma unroll
        for (int b = 0; b < 2; ++b)
#pragma unroll
            for (int m = 0; m < 4; ++m)
#pragma unroll
                for (int n = 0; n < 2; ++n) acc[a][b][m][n] = (f32x4){0.f, 0.f, 0.f, 0.f};
    bf16x8 At[4][2], B0[2][2], B1[2][2];
    int sc1_ = 0x7f7f7f7f; asm volatile("" : "+v"(sc1_));
    unsigned oc[2][2], on[2][2];
    PG8_MKOFF(oc, cur);
    const char* cA = (const char*)g.A + (GATHER ? (size_t)0 : (size_t)cur.pa * tstep); const char* cB = (const char*)g.Bt + (size_t)cur.pb * tstep;
    PG8_STAGE(PG8_SB(0, 0), cB, voffB); PG8_STAGE(PG8_SB(0, 1), cB + hstep, voffB); PG8_STAGE(PG8_SA(0, 0), cA, oc[0]); PG8_STAGE(PG8_SA(0, 1), cA, oc[1]);
    if (wr == 1) PG8_BAR;
    PG8_WAIT_V(2); PG8_BAR;
    PG8_STAGE(PG8_SB(1, 0), cB + kstep, voffB); PG8_STAGE(PG8_SA(1, 0), cA + kstep, oc[0]); PG8_STAGE(PG8_SB(1, 1), cB + hstep + kstep, voffB);
    PG8_WAIT_V(6); PG8_BAR;
    for (;;) {
        const bool has_next = S.next(ui + 1, nxt);
        if (has_next) {
            if constexpr (GATHER) {
#pragma unroll
                for (int _h = 0; _h < 2; ++_h)
#pragma unroll
                    for (int _i = 0; _i < 2; ++_i) asm volatile("global_load_dword %0, %1, off" : "=&v"(on[_h][_i]) : "v"(g.rowmap + (nxt.pm * BM + _h * HALF + RA[_i])) : "memory");
                if (nt < 4) asm volatile("s_waitcnt vmcnt(0)" ::: "memory");
            } else { PG8_MKOFF(on, nxt); }
        } else {
#pragma unroll
            for (int _h = 0; _h < 2; ++_h)
#pragma unroll
                for (int _i = 0; _i < 2; ++_i) on[_h][_i] = oc[_h][_i]; }
        const char* nA = has_next ? (const char*)g.A + (GATHER ? (size_t)0 : (size_t)nxt.pa * tstep) : cA; const char* nB = has_next ? (const char*)g.Bt + (size_t)nxt.pb * tstep : cB;
        for (int t = 0; t < nt; t += 2) {
            const bool last = (t == nt - 2);
            const char* a1 = cA + (size_t)(t + 1) * kstep;
            const char* a2 = last ? nA : cA + (size_t)(t + 2) * kstep; const char* b2 = last ? nB : cB + (size_t)(t + 2) * kstep;
            const char* a3 = a2 + kstep; const char* b3 = b2 + kstep;
            unsigned o2[2][2];
#pragma unroll
            for (int _h = 0; _h < 2; ++_h)
#pragma unroll
                for (int _i = 0; _i < 2; ++_i) {
                    if constexpr (GATHER) { if (last && has_next) { asm volatile("" : "+v"(on[_h][_i])); on[_h][_i] = on[_h][_i] * (unsigned)(K * 2) + colA[_i]; } }
                    o2[_h][_i] = (GATHER && last) ? on[_h][_i] : oc[_h][_i]; }
            PG8_LDB(B0, 0, 0); PG8_LDB(B1, 0, 1); PG8_SCHED; PG8_LDA(At, 0, 0); PG8_STAGE(PG8_SA(1, 1), a1, oc[1]);
            PG8_WAIT_V(8); PG8_WAIT_L(0); PG8_BAR; PG8_MMA(0, 0, At, B0); PG8_MMA(0, 1, At, B1); PG8_BAR; PG8_SCHED;
            PG8_LDA(At, 0, 1); PG8_STAGE(PG8_SB(0, 0), b2, voffB); PG8_STAGE(PG8_SB(0, 1), b2 + hstep, voffB); PG8_STAGE(PG8_SA(0, 0), a2, o2[0]);
            PG8_WAIT_V(8); PG8_WAIT_L(0); PG8_BAR; PG8_MMA(1, 0, At, B0); PG8_MMA(1, 1, At, B1); PG8_BAR; PG8_SCHED;
            PG8_LDB(B0, 1, 0); PG8_LDB(B1, 1, 1); PG8_SCHED; PG8_LDA(At, 1, 0); PG8_STAGE(PG8_SA(0, 1), a2, o2[1]);
            PG8_WAIT_V(8); PG8_WAIT_L(0); PG8_BAR; PG8_MMA(0, 0, At, B0); PG8_MMA(0, 1, At, B1); PG8_BAR; PG8_SCHED;
            PG8_LDA(At, 1, 1); PG8_STAGE(PG8_SB(1, 0), b3, voffB); PG8_STAGE(PG8_SB(1, 1), b3 + hstep, voffB); PG8_STAGE(PG8_SA(1, 0), a3, o2[0]);
            PG8_WAIT_V(8); PG8_WAIT_L(0); PG8_BAR; PG8_MMA(1, 0, At, B0); PG8_MMA(1, 1, At, B1); PG8_BAR; PG8_SCHED;
        }
        if (wr == 0) PG8_BAR;
        if constexpr (FP8) asm volatile("s_nop 15\n\ts_nop 15\n\ts_nop 15" ::: "memory");
        E(acc, cur, wr, wc, fr, fq);
        if (!has_next) break;
#pragma unroll
        for (int a = 0; a < 2; ++a)
#pragma unroll
            for (int b = 0; b < 2; ++b)
#pragma unroll
                for (int m = 0; m < 4; ++m)
#pragma unroll
                    for (int n = 0; n < 2; ++n) acc[a][b][m][n] = (f32x4){0.f, 0.f, 0.f, 0.f};
        cur = nxt; cA = nA; cB = nB; ++ui;
#pragma unroll
        for (int _h = 0; _h < 2; ++_h)
#pragma unroll
            for (int _i = 0; _i < 2; ++_i) oc[_h][_i] = on[_h][_i];
        if (wr == 1) PG8_BAR;
    }
    PG8_WAIT_V(0);
    PG8_BAR;
#undef PG8_SA
#undef PG8_SB
#undef PG8_STAGE
#undef PG8_LDA
#undef PG8_LDB
#undef PG8_MMA
#undef PG8_WAIT_V
#undef PG8_WAIT_L
#undef PG8_BAR
#undef PG8_SCHED
#undef PG8_MKOFF
}
}

namespace att {
constexpr int KBUF = 0, VBUF = 49152, LUTO = 98304, LUTN = 384;
typedef short v4i16_t __attribute__((ext_vector_type(4)));
__device__ __forceinline__ s16x4 vtr(const LAS char* p) { return __builtin_bit_cast(s16x4, __builtin_amdgcn_ds_read_tr16_b64_v4i16((LAS v4i16_t*)p)); }
__device__ __forceinline__ void glds16(const void* gsrc, unsigned lds_dst) { unsigned keep;
    asm volatile("s_mov_b32 %0, m0\n\ts_mov_b32 m0, %2\n\ts_nop 0\n\tglobal_load_lds_dwordx4 %1, off\n\ts_mov_b32 m0, %0" : "=&s"(keep) : "v"(gsrc), "s"(lds_dst) : "memory"); }

struct Job {
    int b, dil, rho, U0, kt_lo, kt_hi;
    int qG, kG, vG, lutid;
    bf16* O; float* L; int opitch, ooff, lpitch, loff;
    float lam, oml; const float* sg;
};

template <int DV, bool WINDOW>
__device__ __forceinline__ void unit(LAS unsigned char* lds, const bf16* __restrict__ QKV, const float* __restrict__ RLUT, const Job& J) {
    constexpr int NDH = DV / 32;
    const int tid = opq(threadIdx.x), lane = tid & 63, r32 = lane & 31, hi = lane >> 5;
    const int wid = __builtin_amdgcn_readfirstlane(tid >> 6), hsel = wid >> 2, w4 = wid & 3;
    const size_t tb = (size_t)J.b * SEQ;
    const bf16* Qg = QKV + ((size_t)J.qG * NT + tb) * 64;
    const bf16* Kg = QKV + ((size_t)J.kG * NT + tb) * 64;
    const bf16* Vg = QKV + ((size_t)J.vG * NT + tb) * 64;
    const int dil = J.dil, rho = J.rho;
    asm volatile("s_waitcnt lgkmcnt(0)\n\ts_barrier" ::: "memory");
    const unsigned lds0 = (unsigned)(uintptr_t)lds;
#define ATT_LOADS(s_, slot, cbase, ncnt) do { const int k0_ = (J.kt_lo + (s_)) * 64; \
        _Pragma("unroll") for (int pp = 0; pp < (ncnt); ++pp) { const int c_ = (cbase) + pp; \
            glds16(Kg + (size_t)(rho + dil * (k0_ + 8 * c_ + (lane >> 3))) * 64 + ((lane & 7) ^ (lane >> 3)) * 8, (unsigned)__builtin_amdgcn_readfirstlane(lds0 + KBUF + (slot) * 16384 + hsel * 8192 + c_ * 1024)); } \
        _Pragma("unroll") for (int pp = 0; pp < (ncnt); ++pp) { const int p_ = (cbase) + pp, dh_ = p_ >> 2, kg_ = p_ & 3; \
            glds16(Vg + (size_t)(rho + dil * (k0_ + 16 * kg_ + (lane >> 2))) * 64 + dh_ * 32 + (lane & 3) * 8, (unsigned)__builtin_amdgcn_readfirstlane(lds0 + VBUF + (slot) * 16384 + hsel * 8192 + p_ * 1024)); } } while (0)
    const int par = w4 & 1, cb4 = 4 * (w4 >> 1), S = J.kt_hi - J.kt_lo;
    ATT_LOADS(0, 0, 2 * w4, 2);
    if (par == 1) ATT_LOADS(1, 1, cb4, 4);
    const int Q0w = J.U0 + 32 * w4;
    bf16x8 qr[4];
    { const bf16* qrow = Qg + (size_t)(rho + dil * (Q0w + r32)) * 64 + hi * 8;
#pragma unroll
      for (int d0 = 0; d0 < 4; ++d0) qr[d0] = *(const bf16x8*)(qrow + d0 * 16); }
    { LAS float* L = (LAS float*)(lds + LUTO + hsel * (LUTN * 4)); const float* src = RLUT + (size_t)J.lutid * LUTN; const int i = tid & 255;
      L[i] = src[i]; if (i < LUTN - 256) L[256 + i] = src[256 + i]; }
    f32x16 o[NDH];
#pragma unroll
    for (int i = 0; i < NDH; ++i) o[i] = f32x16{};
    float lsum = 0.f;
    const LAS char* kfb = (const LAS char*)(lds + KBUF + hsel * 8192 + r32 * 128);
    int koff[4];
#pragma unroll
    for (int d0 = 0; d0 < 4; ++d0) koff[d0] = (((2 * d0 + hi) ^ (r32 & 7)) << 4);
    const LAS char* vfb = (const LAS char*)(lds + VBUF + (DV == 64 ? hsel * 8192 : 0) + ((lane >> 4) & 1) * 32 + (lane & 3) * 8 + (4 * hi + ((lane & 15) >> 2)) * 64);
    const LAS char* lutb = (const LAS char*)(lds + LUTO + hsel * (LUTN * 4));
    int buf = 0, bufn = 2;
    for (int kt = J.kt_lo; kt < J.kt_hi; ++kt) {
        const int sst = kt - J.kt_lo;
        if (sst == 0 || (sst & 1) == par) asm volatile("s_waitcnt vmcnt(0) lgkmcnt(0)\n\ts_barrier" ::: "memory"); else asm volatile("s_waitcnt lgkmcnt(0)\n\ts_barrier" ::: "memory");
        if ((sst & 1) == par && sst + 2 < S) ATT_LOADS(sst + 2, bufn, cb4, 4);
        const int k0 = kt * 64, dq = Q0w - k0;
        const bool need = WINDOW ? (dq >= -31 && dq <= 191) : true;
        if (need) {
            f32x16 c0, c1;
            if (!WINDOW && dq >= 191) {
                const float cf = *(const LAS float*)(lutb + (383 - 256) * 4);
#pragma unroll
                for (int r = 0; r < 16; ++r) { c0[r] = cf; c1[r] = cf; }
            } else {
                unsigned lpo_ = (unsigned)(uintptr_t)(lutb + (255 - dq - r32 + 4 * hi) * 4); asm volatile("" : "+v"(lpo_));
                const LAS char* lp = (const LAS char*)(uintptr_t)lpo_;
#pragma unroll
                for (int r = 0; r < 16; ++r) { const int off = ((r & 3) + 8 * (r >> 2)) * 4; c0[r] = *(const LAS float*)(lp + off); c1[r] = *(const LAS float*)(lp + off + 128); }
            }
            const LAS char* kp = kfb + buf * 16384;
            const LAS char* vp = vfb + buf * 16384;
            bf16x8 kf[8];
#pragma unroll
            for (int d0 = 0; d0 < 4; ++d0) { kf[2 * d0] = *(const LAS bf16x8*)(kp + koff[d0]); kf[2 * d0 + 1] = *(const LAS bf16x8*)(kp + koff[d0] + 4096); }
            __builtin_amdgcn_sched_barrier(0);
#pragma unroll
            for (int d0 = 0; d0 < 4; ++d0) {
                c0 = __builtin_amdgcn_mfma_f32_32x32x16_bf16(kf[2 * d0], qr[d0], c0, 0, 0, 0);
                c1 = __builtin_amdgcn_mfma_f32_32x32x16_bf16(kf[2 * d0 + 1], qr[d0], c1, 0, 0, 0);
            }
            s16x4 vl[8], vh[8];
#define ATT_VREAD(b) do { _Pragma("unroll") for (int i_ = 0; i_ < 8; ++i_) { vl[i_] = vtr(vp + ((b) * 2 + (i_ >> 2)) * 4096 + (i_ & 3) * 1024); vh[i_] = vtr(vp + ((b) * 2 + (i_ >> 2)) * 4096 + (i_ & 3) * 1024 + 512); } } while (0)
#define ATT_PV(b) do { _Pragma("unroll") for (int i_ = 0; i_ < 8; ++i_) { const bf16x8 vf_ = (bf16x8){vl[i_][0], vl[i_][1], vl[i_][2], vl[i_][3], vh[i_][0], vh[i_][1], vh[i_][2], vh[i_][3]}; \
                o[(b) * 2 + (i_ >> 2)] = __builtin_amdgcn_mfma_f32_32x32x16_bf16(vf_, __builtin_bit_cast(bf16x8, pw[i_ & 3]), o[(b) * 2 + (i_ >> 2)], 0, 0, 0); } } while (0)
            ATT_VREAD(0);
            float s0 = 0.f, s1 = 0.f;
#pragma unroll
            for (int r = 0; r < 16; ++r) { c0[r] = __builtin_amdgcn_exp2f(c0[r]); c1[r] = __builtin_amdgcn_exp2f(c1[r]); s0 += c0[r]; s1 += c1[r]; }
            lsum += s0 + s1;
            u32x4 pw[4];
#pragma unroll
            for (int s = 0; s < 2; ++s) {
                pw[s] = (u32x4){cvt_pk_bf16(c0[8 * s], c0[8 * s + 1]), cvt_pk_bf16(c0[8 * s + 2], c0[8 * s + 3]), cvt_pk_bf16(c0[8 * s + 4], c0[8 * s + 5]), cvt_pk_bf16(c0[8 * s + 6], c0[8 * s + 7])};
                pw[2 + s] = (u32x4){cvt_pk_bf16(c1[8 * s], c1[8 * s + 1]), cvt_pk_bf16(c1[8 * s + 2], c1[8 * s + 3]), cvt_pk_bf16(c1[8 * s + 4], c1[8 * s + 5]), cvt_pk_bf16(c1[8 * s + 6], c1[8 * s + 7])};
            }
            ATT_PV(0);
            if constexpr (NDH == 4) { ATT_VREAD(1); ATT_PV(1); }
#undef ATT_VREAD
#undef ATT_PV
        }
        bufn = buf; buf = (buf == 2) ? 0 : buf + 1;
    }
#undef ATT_LOADS
    { auto rr = __builtin_amdgcn_permlane32_swap(__float_as_uint(lsum), __float_as_uint(lsum), false, false); lsum = __uint_as_float(rr[0]) + __uint_as_float(rr[1]); }
    const size_t tok = tb + (size_t)(rho + dil * (Q0w + r32));
    if constexpr (DV == 128) {
        LAS float* X = (LAS float*)lds;
        __syncthreads();
        if (hsel == 1) { const float sc = J.lam / lsum;
#pragma unroll
            for (int dh = 0; dh < 4; ++dh)
#pragma unroll
                for (int r = 0; r < 16; ++r) X[((w4 * 4 + dh) * 16 + r) * 64 + lane] = o[dh][r] * sc; }
        __syncthreads();
        if (hsel == 0) { const float r1 = 1.f / lsum; float ss = 0.f;
            f32x4 gq[4][4];
#pragma unroll
            for (int dh = 0; dh < 4; ++dh)
#pragma unroll
                for (int g4 = 0; g4 < 4; ++g4) gq[dh][g4] = *(const f32x4*)(J.sg + 32 * dh + 8 * g4 + 4 * hi);
#pragma unroll
            for (int dh = 0; dh < 4; ++dh)
#pragma unroll
                for (int r = 0; r < 16; ++r) { const float a = o[dh][r] * r1 - X[((w4 * 4 + dh) * 16 + r) * 64 + lane]; o[dh][r] = a; ss += a * a; }
            { auto rr = __builtin_amdgcn_permlane32_swap(__float_as_uint(ss), __float_as_uint(ss), false, false); ss = __uint_as_float(rr[0]) + __uint_as_float(rr[1]); }
            const float rn = J.oml / sqrtf(ss * (1.f / 128.f) + EPS);
            bf16* orow = J.O + tok * J.opitch + J.ooff + 4 * hi;
#pragma unroll
            for (int dh = 0; dh < 4; ++dh)
#pragma unroll
                for (int g4 = 0; g4 < 4; ++g4) { const f32x4 g = gq[dh][g4];
                    u32x2 w; w.x = cvt_pk_bf16(o[dh][4 * g4] * rn * g[0], o[dh][4 * g4 + 1] * rn * g[1]); w.y = cvt_pk_bf16(o[dh][4 * g4 + 2] * rn * g[2], o[dh][4 * g4 + 3] * rn * g[3]);
                    *(u32x2*)(orow + 32 * dh + 8 * g4) = w; } }
    } else {
        bf16* orow = J.O + tok * J.opitch + J.ooff + 4 * hi;
#pragma unroll
        for (int dh = 0; dh < NDH; ++dh)
#pragma unroll
            for (int g4 = 0; g4 < 4; ++g4) {
                u32x2 w; w.x = cvt_pk_bf16(o[dh][4 * g4], o[dh][4 * g4 + 1]); w.y = cvt_pk_bf16(o[dh][4 * g4 + 2], o[dh][4 * g4 + 3]);
                *(u32x2*)(orow + 32 * dh + 8 * g4) = w;
            }
        if (hi == 0) J.L[tok * J.lpitch + J.loff] = lsum;
    }
}

struct JobA { int br, dil, rho, n, lo, nt; };
__device__ __forceinline__ JobA job_a(int j) { JobA q;
    if (j < 16) { q.br = 0; q.rho = 0; q.n = j; q.dil = 1; } else if (j < 32) { q.br = 1; q.rho = (j - 16) >> 2; q.n = (j - 16) & 3; q.dil = 4; } else { q.br = 2; q.rho = j - 32; q.n = 0; q.dil = 16; }
    q.lo = q.n > 0 ? 2 * q.n - 2 : 0; q.nt = q.n > 0 ? 4 : 2; return q; }
__device__ __forceinline__ void unit_a3(LAS unsigned char* lds, const bf16* __restrict__ QKV, const float* __restrict__ RLUT, bf16* PARTA_, float* LA_, int b, int hp, int g) {
    constexpr int LUT3 = LUTO;
    const int tid = opq(threadIdx.x), lane = tid & 63, r32 = lane & 31, hi = lane >> 5;
    const int wid = __builtin_amdgcn_readfirstlane(tid >> 6), hsel = wid >> 2, w4 = wid & 3, head = 2 * hp + hsel;
    const size_t tb = (size_t)b * SEQ;
    const bf16* Qg = QKV + ((size_t)head * NT + tb) * 64;
    const bf16* Kg = QKV + ((size_t)(8 + head) * NT + tb) * 64;
    const bf16* Vg = QKV + ((size_t)(16 + head) * NT + tb) * 64;
    const JobA j0 = job_a(3 * g), j1 = job_a(3 * g + 1), j2 = job_a(3 * g + 2);
    const int c1 = j0.nt, c2 = j0.nt + j1.nt, S = c2 + j2.nt;
#define JSEL(k, f) ((k) == 0 ? j0.f : (k) == 1 ? j1.f : j2.f)
    const unsigned lds0 = (unsigned)(uintptr_t)lds;
    __syncthreads();
#define ATT_LOADS(s_, slot, cbase, ncnt) do { const int k_ = ((s_) >= c1) + ((s_) >= c2); const int kt_ = JSEL(k_, lo) + (s_) - (k_ == 0 ? 0 : k_ == 1 ? c1 : c2); \
        const int k0_ = kt_ * 64, rho_ = JSEL(k_, rho), dil_ = JSEL(k_, dil); \
        _Pragma("unroll") for (int pp = 0; pp < (ncnt); ++pp) { const int c_ = (cbase) + pp; \
            glds16(Kg + (size_t)(rho_ + dil_ * (k0_ + 8 * c_ + (lane >> 3))) * 64 + ((lane & 7) ^ (lane >> 3)) * 8, (unsigned)__builtin_amdgcn_readfirstlane(lds0 + KBUF + (slot) * 16384 + hsel * 8192 + c_ * 1024)); } \
        _Pragma("unroll") for (int pp = 0; pp < (ncnt); ++pp) { const int p_ = (cbase) + pp, dh_ = p_ >> 2, kg_ = p_ & 3; \
            glds16(Vg + (size_t)(rho_ + dil_ * (k0_ + 16 * kg_ + (lane >> 2))) * 64 + dh_ * 32 + (lane & 3) * 8, (unsigned)__builtin_amdgcn_readfirstlane(lds0 + VBUF + (slot) * 16384 + hsel * 8192 + p_ * 1024)); } } while (0)
#define ATT_BAR_VM0() asm volatile("s_waitcnt vmcnt(0) lgkmcnt(0)\n\ts_barrier" ::: "memory")
#define ATT_BAR() asm volatile("s_waitcnt lgkmcnt(0)\n\ts_barrier" ::: "memory")
#define ATT_QLOAD(dst, k) do { const bf16* qrow_ = Qg + (size_t)(JSEL(k, rho) + JSEL(k, dil) * (128 * JSEL(k, n) + 32 * w4 + r32)) * 64 + hi * 8; \
        _Pragma("unroll") for (int d0 = 0; d0 < 4; ++d0) dst[d0] = *(const bf16x8*)(qrow_ + d0 * 16); } while (0)
    const int par = w4 & 1, cb4 = 4 * (w4 >> 1);
    ATT_LOADS(0, 0, 2 * w4, 2);
    if (par == 1) ATT_LOADS(1, 1, cb4, 4);
    bf16x8 qr[4], q1[4], q2[4];
    ATT_QLOAD(qr, 0); ATT_QLOAD(q1, 1); ATT_QLOAD(q2, 2);
    { LAS float* L = (LAS float*)(lds + LUT3 + hsel * (3 * LUTN * 4)); const int i = tid & 255;
#pragma unroll
      for (int k = 0; k < 3; ++k) { const float* src = RLUT + (size_t)(JSEL(k, br) * 8 + head) * LUTN; L[k * LUTN + i] = src[i]; if (i < LUTN - 256) L[k * LUTN + 256 + i] = src[256 + i]; } }
    f32x16 o[2]; o[0] = f32x16{}; o[1] = f32x16{};
    float lsum = 0.f;
    const LAS char* kfb = (const LAS char*)(lds + KBUF + hsel * 8192 + r32 * 128);
    int koff[4];
#pragma unroll
    for (int d0 = 0; d0 < 4; ++d0) koff[d0] = (((2 * d0 + hi) ^ (r32 & 7)) << 4);
    const LAS char* vfb = (const LAS char*)(lds + VBUF + hsel * 8192 + ((lane >> 4) & 1) * 32 + (lane & 3) * 8 + (4 * hi + ((lane & 15) >> 2)) * 64);
    int buf = 0, bufn = 2;
    for (int s = 0; s < S; ++s) {
        if (s == 0 || (s & 1) == par) ATT_BAR_VM0(); else ATT_BAR();
        if ((s & 1) == par && s + 2 < S) ATT_LOADS(s + 2, bufn, cb4, 4);
        const int k = (s >= c1) + (s >= c2), cs = k == 0 ? 0 : k == 1 ? c1 : c2;
        const int kt = JSEL(k, lo) + s - cs, Q0w = 128 * JSEL(k, n) + 32 * w4;
        if (s == cs && k > 0) {
#pragma unroll
            for (int d0 = 0; d0 < 4; ++d0) qr[d0] = (k == 1) ? q1[d0] : q2[d0];
            o[0] = f32x16{}; o[1] = f32x16{}; lsum = 0.f;
        }
        const int dq = Q0w - kt * 64;
        const bool need = (dq >= -31) && (dq <= 191);
        if (need) {
            f32x16 c0, c1;
            { const LAS char* lp = (const LAS char*)(lds + LUT3 + hsel * (3 * LUTN * 4) + k * (LUTN * 4)) + (255 - dq - r32 + 4 * hi) * 4;
#pragma unroll
              for (int r = 0; r < 16; ++r) { const int off = ((r & 3) + 8 * (r >> 2)) * 4; c0[r] = *(const LAS float*)(lp + off); c1[r] = *(const LAS float*)(lp + off + 128); } }
            const LAS char* kp = kfb + buf * 16384;
            const LAS char* vp = vfb + buf * 16384;
            bf16x8 kf[8];
#pragma unroll
            for (int d0 = 0; d0 < 4; ++d0) { kf[2 * d0] = *(const LAS bf16x8*)(kp + koff[d0]); kf[2 * d0 + 1] = *(const LAS bf16x8*)(kp + koff[d0] + 4096); }
            __builtin_amdgcn_sched_barrier(0);
#pragma unroll
            for (int d0 = 0; d0 < 4; ++d0) {
                c0 = __builtin_amdgcn_mfma_f32_32x32x16_bf16(kf[2 * d0], qr[d0], c0, 0, 0, 0);
                c1 = __builtin_amdgcn_mfma_f32_32x32x16_bf16(kf[2 * d0 + 1], qr[d0], c1, 0, 0, 0);
            }
            s16x4 vl[8], vh[8];
#pragma unroll
            for (int i_ = 0; i_ < 8; ++i_) { vl[i_] = vtr(vp + (i_ >> 2) * 4096 + (i_ & 3) * 1024); vh[i_] = vtr(vp + (i_ >> 2) * 4096 + (i_ & 3) * 1024 + 512); }
            float s0 = 0.f, s1 = 0.f;
#pragma unroll
            for (int r = 0; r < 16; ++r) { c0[r] = __builtin_amdgcn_exp2f(c0[r]); c1[r] = __builtin_amdgcn_exp2f(c1[r]); s0 += c0[r]; s1 += c1[r]; }
            lsum += s0 + s1;
            u32x4 pw[4];
#pragma unroll
            for (int q = 0; q < 2; ++q) {
                pw[q] = (u32x4){cvt_pk_bf16(c0[8 * q], c0[8 * q + 1]), cvt_pk_bf16(c0[8 * q + 2], c0[8 * q + 3]), cvt_pk_bf16(c0[8 * q + 4], c0[8 * q + 5]), cvt_pk_bf16(c0[8 * q + 6], c0[8 * q + 7])};
                pw[2 + q] = (u32x4){cvt_pk_bf16(c1[8 * q], c1[8 * q + 1]), cvt_pk_bf16(c1[8 * q + 2], c1[8 * q + 3]), cvt_pk_bf16(c1[8 * q + 4], c1[8 * q + 5]), cvt_pk_bf16(c1[8 * q + 6], c1[8 * q + 7])};
            }
#pragma unroll
            for (int i_ = 0; i_ < 8; ++i_) { const bf16x8 vf_ = (bf16x8){vl[i_][0], vl[i_][1], vl[i_][2], vl[i_][3], vh[i_][0], vh[i_][1], vh[i_][2], vh[i_][3]};
                o[i_ >> 2] = __builtin_amdgcn_mfma_f32_32x32x16_bf16(vf_, __builtin_bit_cast(bf16x8, pw[i_ & 3]), o[i_ >> 2], 0, 0, 0); }
        }
        if (s + 1 == (k == 0 ? c1 : k == 1 ? c2 : S)) {
            float lt = lsum;
            { auto rr = __builtin_amdgcn_permlane32_swap(__float_as_uint(lt), __float_as_uint(lt), false, false); lt = __uint_as_float(rr[0]) + __uint_as_float(rr[1]); }
            const int br = JSEL(k, br);
            const size_t tok = tb + (size_t)(JSEL(k, rho) + JSEL(k, dil) * (Q0w + r32));
            bf16* orow = PARTA_ + ((size_t)br * NT + tok) * 512 + head * 64 + 4 * hi;
#pragma unroll
            for (int dh = 0; dh < 2; ++dh)
#pragma unroll
                for (int g4 = 0; g4 < 4; ++g4) {
                    u32x2 w; w.x = cvt_pk_bf16(o[dh][4 * g4], o[dh][4 * g4 + 1]); w.y = cvt_pk_bf16(o[dh][4 * g4 + 2], o[dh][4 * g4 + 3]);
                    *(u32x2*)(orow + 32 * dh + 8 * g4) = w;
                }
            if (hi == 0) LA_[((size_t)br * NT + tok) * 8 + head] = lt;
        }
        bufn = buf; buf = (buf == 2) ? 0 : buf + 1;
    }
    asm volatile("s_waitcnt lgkmcnt(0)" ::: "memory");
#undef ATT_LOADS
#undef ATT_BAR_VM0
#undef ATT_BAR
#undef ATT_QLOAD
#undef JSEL
}
__device__ __forceinline__ void unit_a12(LAS unsigned char* lds, const bf16* __restrict__ QKV, const float* __restrict__ RLUT, bf16* PARTA_, float* LA_, int b, int hp, int q) {
    constexpr int LUT3 = LUTO;
    const int tid = opq(threadIdx.x), lane = tid & 63, r32 = lane & 31, hi = lane >> 5;
    const int wid = __builtin_amdgcn_readfirstlane(tid >> 6), hsel = wid >> 2, w4 = wid & 3, head = 2 * hp + hsel;
    const size_t tb = (size_t)b * SEQ;
    const bf16* Qg = QKV + ((size_t)head * NT + tb) * 64;
    const bf16* Kg = QKV + ((size_t)(8 + head) * NT + tb) * 64;
    const bf16* Vg = QKV + ((size_t)(16 + head) * NT + tb) * 64;
#define JID(jj) (3 * (q + 4 * ((jj) / 3)) + (jj) % 3)
    int S = 0;
    for (int jj = 0; jj < 12; ++jj) S += job_a(JID(jj)).nt;
    int kl = 0, csl = 0; JobA jl = job_a(JID(0)); int cel = jl.nt;
#define ATT_LC_ADV(s_) do { if ((s_) >= cel && kl + 1 < 12) { ++kl; jl = job_a(JID(kl)); csl = cel; cel += jl.nt; } } while (0)
    const unsigned lds0 = (unsigned)(uintptr_t)lds;
    __syncthreads();
#define ATT_LOADS(s_, slot, cbase, ncnt) do { const int kt_ = jl.lo + (s_) - csl; \
        const int k0_ = kt_ * 64, rho_ = jl.rho, dil_ = jl.dil; \
        _Pragma("unroll") for (int pp = 0; pp < (ncnt); ++pp) { const int c_ = (cbase) + pp; \
            glds16(Kg + (size_t)(rho_ + dil_ * (k0_ + 8 * c_ + (lane >> 3))) * 64 + ((lane & 7) ^ (lane >> 3)) * 8, (unsigned)__builtin_amdgcn_readfirstlane(lds0 + KBUF + (slot) * 16384 + hsel * 8192 + c_ * 1024)); } \
        _Pragma("unroll") for (int pp = 0; pp < (ncnt); ++pp) { const int p_ = (cbase) + pp, dh_ = p_ >> 2, kg_ = p_ & 3; \
            glds16(Vg + (size_t)(rho_ + dil_ * (k0_ + 16 * kg_ + (lane >> 2))) * 64 + dh_ * 32 + (lane & 3) * 8, (unsigned)__builtin_amdgcn_readfirstlane(lds0 + VBUF + (slot) * 16384 + hsel * 8192 + p_ * 1024)); } } while (0)
#define ATT_BAR_VM0() asm volatile("s_waitcnt vmcnt(0) lgkmcnt(0)\n\ts_barrier" ::: "memory")
#define ATT_BAR() asm volatile("s_waitcnt lgkmcnt(0)\n\ts_barrier" ::: "memory")
#define ATT_QLOAD(dst, J_) do { const bf16* qrow_ = Qg + (size_t)(J_.rho + J_.dil * (128 * J_.n + 32 * w4 + r32)) * 64 + hi * 8; \
        _Pragma("unroll") for (int d0 = 0; d0 < 4; ++d0) asm volatile("global_load_dwordx4 %0, %1, off" : "=&v"(dst[d0]) : "v"(qrow_ + d0 * 16) : "memory"); } while (0)
    const int par = w4 & 1, cb4 = 4 * (w4 >> 1);
    ATT_LOADS(0, 0, 2 * w4, 2);
    ATT_LC_ADV(1);
    if (par == 1) ATT_LOADS(1, 1, cb4, 4);
    int kc = 0, csc = 0; JobA jc = job_a(JID(0)), jn = job_a(JID(1)); int cec = jc.nt;
    bf16x8 qr[4], qn[4];
    ATT_QLOAD(qr, jc); ATT_QLOAD(qn, jn);
    { LAS float* L = (LAS float*)(lds + LUT3 + hsel * (3 * LUTN * 4)); const int i = tid & 255;
#pragma unroll
      for (int k = 0; k < 3; ++k) { const float* src = RLUT + (size_t)(k * 8 + head) * LUTN; L[k * LUTN + i] = src[i]; if (i < LUTN - 256) L[k * LUTN + 256 + i] = src[256 + i]; } }
    f32x16 o[2]; o[0] = f32x16{}; o[1] = f32x16{};
    float lsum = 0.f;
    const LAS char* kfb = (const LAS char*)(lds + KBUF + hsel * 8192 + r32 * 128);
    int koff[4];
#pragma unroll
    for (int d0 = 0; d0 < 4; ++d0) koff[d0] = (((2 * d0 + hi) ^ (r32 & 7)) << 4);
    const LAS char* vfb = (const LAS char*)(lds + VBUF + hsel * 8192 + ((lane >> 4) & 1) * 32 + (lane & 3) * 8 + (4 * hi + ((lane & 15) >> 2)) * 64);
    int buf = 0, bufn = 2;
    for (int s = 0; s < S; ++s) {
        if (s == 0 || (s & 1) == par) ATT_BAR_VM0(); else ATT_BAR();
        ATT_LC_ADV(s + 2);
        if ((s & 1) == par && s + 2 < S) ATT_LOADS(s + 2, bufn, cb4, 4);
        if (s == cec) {
            ++kc; jc = jn; csc = cec; cec += jc.nt;
#pragma unroll
            for (int d0 = 0; d0 < 4; ++d0) { asm volatile("" : "+v"(qn[d0])); qr[d0] = qn[d0]; }
            o[0] = f32x16{}; o[1] = f32x16{}; lsum = 0.f;
            if (kc + 1 < 12) { jn = job_a(JID(kc + 1)); ATT_QLOAD(qn, jn); }
        }
        const int kt = jc.lo + s - csc, Q0w = 128 * jc.n + 32 * w4;
        const int dq = Q0w - kt * 64;
        const bool need = (dq >= -31) && (dq <= 191);
        if (need) {
            f32x16 c0, c1;
            { unsigned lpo_ = (unsigned)(uintptr_t)((const LAS char*)(lds + LUT3 + hsel * (3 * LUTN * 4) + jc.br * (LUTN * 4)) + (255 - dq - r32 + 4 * hi) * 4); asm volatile("" : "+v"(lpo_));
              const LAS char* lp = (const LAS char*)(uintptr_t)lpo_;
#pragma unroll
              for (int r = 0; r < 16; ++r) { const int off = ((r & 3) + 8 * (r >> 2)) * 4; c0[r] = *(const LAS float*)(lp + off); c1[r] = *(const LAS float*)(lp + off + 128); } }
            const LAS char* kp = kfb + buf * 16384;
            const LAS char* vp = vfb + buf * 16384;
            bf16x8 kf[8];
#pragma unroll
            for (int d0 = 0; d0 < 4; ++d0) { kf[2 * d0] = *(const LAS bf16x8*)(kp + koff[d0]); kf[2 * d0 + 1] = *(const LAS bf16x8*)(kp + koff[d0] + 4096); }
            __builtin_amdgcn_sched_barrier(0);
#pragma unroll
            for (int d0 = 0; d0 < 4; ++d0) {
                c0 = __builtin_amdgcn_mfma_f32_32x32x16_bf16(kf[2 * d0], qr[d0], c0, 0, 0, 0);
                c1 = __builtin_amdgcn_mfma_f32_32x32x16_bf16(kf[2 * d0 + 1], qr[d0], c1, 0, 0, 0);
            }
            s16x4 vl[8], vh[8];
#pragma unroll
            for (int i_ = 0; i_ < 8; ++i_) { vl[i_] = vtr(vp + (i_ >> 2) * 4096 + (i_ & 3) * 1024); vh[i_] = vtr(vp + (i_ >> 2) * 4096 + (i_ & 3) * 1024 + 512); }
            float s0 = 0.f, s1 = 0.f;
#pragma unroll
            for (int r = 0; r < 16; ++r) { c0[r] = __builtin_amdgcn_exp2f(c0[r]); c1[r] = __builtin_amdgcn_exp2f(c1[r]); s0 += c0[r]; s1 += c1[r]; }
            lsum += s0 + s1;
            u32x4 pw[4];
#pragma unroll
            for (int q = 0; q < 2; ++q) {
                pw[q] = (u32x4){cvt_pk_bf16(c0[8 * q], c0[8 * q + 1]), cvt_pk_bf16(c0[8 * q + 2], c0[8 * q + 3]), cvt_pk_bf16(c0[8 * q + 4], c0[8 * q + 5]), cvt_pk_bf16(c0[8 * q + 6], c0[8 * q + 7])};
                pw[2 + q] = (u32x4){cvt_pk_bf16(c1[8 * q], c1[8 * q + 1]), cvt_pk_bf16(c1[8 * q + 2], c1[8 * q + 3]), cvt_pk_bf16(c1[8 * q + 4], c1[8 * q + 5]), cvt_pk_bf16(c1[8 * q + 6], c1[8 * q + 7])};
            }
#pragma unroll
            for (int i_ = 0; i_ < 8; ++i_) { const bf16x8 vf_ = (bf16x8){vl[i_][0], vl[i_][1], vl[i_][2], vl[i_][3], vh[i_][0], vh[i_][1], vh[i_][2], vh[i_][3]};
                o[i_ >> 2] = __builtin_amdgcn_mfma_f32_32x32x16_bf16(vf_, __builtin_bit_cast(bf16x8, pw[i_ & 3]), o[i_ >> 2], 0, 0, 0); }
        }
        if (s + 1 == cec) {
            float lt = lsum;
            { auto rr = __builtin_amdgcn_permlane32_swap(__float_as_uint(lt), __float_as_uint(lt), false, false); lt = __uint_as_float(rr[0]) + __uint_as_float(rr[1]); }
            const int br = jc.br;
            const size_t tok = tb + (size_t)(jc.rho + jc.dil * (Q0w + r32));
            bf16* orow = PARTA_ + ((size_t)br * NT + tok) * 512 + head * 64 + 4 * hi;
#pragma unroll
            for (int dh = 0; dh < 2; ++dh)
#pragma unroll
                for (int g4 = 0; g4 < 4; ++g4) {
                    u32x2 w; w.x = cvt_pk_bf16(o[dh][4 * g4], o[dh][4 * g4 + 1]); w.y = cvt_pk_bf16(o[dh][4 * g4 + 2], o[dh][4 * g4 + 3]);
                    *(u32x2*)(orow + 32 * dh + 8 * g4) = w;
                }
            if (hi == 0) LA_[((size_t)br * NT + tok) * 8 + head] = lt;
        }
        bufn = buf; buf = (buf == 2) ? 0 : buf + 1;
    }
    asm volatile("s_waitcnt lgkmcnt(0)" ::: "memory");
#undef ATT_LOADS
#undef ATT_BAR_VM0
#undef ATT_BAR
#undef ATT_QLOAD
#undef JID
#undef ATT_LC_ADV
}
}

#define XB_TMO      128
#define XB_XCNT(j)  (256  + 64 * (j))
#define XB_XSUB(j)  (1280 + 64 * (j))
#define XB_XGEN(j)  (2304 + 64 * (j))
#define XB_TOP      3328
#define XB_TOPGEN   3392
#define XCD_BAR_WORDS 3456
#define XB_SPIN_CAP (1u << 18)
__device__ __forceinline__ unsigned xb_ld(unsigned* p)              { return __hip_atomic_load(p, __ATOMIC_RELAXED, __HIP_MEMORY_SCOPE_AGENT); }
__device__ __forceinline__ unsigned xb_add(unsigned* p, unsigned v) { return __hip_atomic_fetch_add(p, v, __ATOMIC_RELAXED, __HIP_MEMORY_SCOPE_AGENT); }
__device__ __forceinline__ unsigned xb_xcc_id() { return (unsigned)__builtin_amdgcn_s_getreg((3 << 11) | 20) & 0xFu; }
#define XB_SPIN(cond, bar) do { unsigned _sp = 0; while (cond) { __builtin_amdgcn_s_sleep(1); \
    if ((++_sp & 255u) == 0u) { if (xb_ld(&(bar)[XB_TMO])) break; if (_sp > XB_SPIN_CAP) { atomicAdd(&(bar)[XB_TMO], 1u); break; } } } } while (0)
struct XcdBarrier { unsigned* bar; unsigned x; volatile LAS unsigned* st; };
__device__ __forceinline__ XcdBarrier xcd_barrier_post(unsigned* bar, volatile LAS unsigned* st) {
    XcdBarrier b; b.bar = bar; b.x = xb_xcc_id(); b.st = st;
    if (threadIdx.x == 0) (void)xb_add(&bar[XB_XCNT(b.x)], 1u);
    return b;
}
__device__ __forceinline__ void xcd_barrier_complete(unsigned* bar, unsigned x, unsigned& nloc, unsigned& nx) {
    const unsigned G = gridDim.x * gridDim.y * gridDim.z;
    unsigned sum, cnt, mine, sp = 0u;
    for (;;) {
        sum = 0u; cnt = 0u; mine = 0u;
#pragma unroll
        for (unsigned j = 0; j < 16; ++j) { const unsigned c = xb_ld(&bar[XB_XCNT(j)]); sum += c; cnt += (c > 0u) ? 1u : 0u; mine = (j == x) ? c : mine; }
        if (sum == G) break;
        __builtin_amdgcn_s_sleep(1);
        if ((++sp & 255u) == 0u) { if (xb_ld(&bar[XB_TMO])) break; if (sp > XB_SPIN_CAP) { atomicAdd(&bar[XB_TMO], 1u); break; } }
    }
    nloc = mine > 0u ? mine : 1u; nx = cnt > 0u ? cnt : 1u;
}
__device__ __forceinline__ void xcd_barrier(const XcdBarrier& b) {
    asm volatile("s_waitcnt vmcnt(0)" ::: "memory");
    __syncthreads();
    if (threadIdx.x == 0) {
        unsigned* bar = b.bar;
        __builtin_amdgcn_s_waitcnt(0);
        unsigned nloc = b.st[0], nx = b.st[1];
        if (nloc == 0u) { xcd_barrier_complete(bar, b.x, nloc, nx); b.st[0] = nloc; b.st[1] = nx; }
        const unsigned old = xb_add(&bar[XB_XSUB(b.x)], 1u);
        const unsigned gen = old / nloc;
        if (old + 1u == (gen + 1u) * nloc) {
            __builtin_amdgcn_fence(__ATOMIC_RELEASE, "agent");
            asm volatile("s_waitcnt vmcnt(0)" ::: "memory");
            const unsigned og = xb_add(&bar[XB_TOP], 1u);
            const unsigned tg = og / nx;
            if (og + 1u == (tg + 1u) * nx) xb_add(&bar[XB_TOPGEN], 1u);
            else XB_SPIN(xb_ld(&bar[XB_TOPGEN]) == tg, bar);
            __builtin_amdgcn_fence(__ATOMIC_ACQUIRE, "agent");
            xb_add(&bar[XB_XGEN(b.x)], 1u);
            asm volatile("s_waitcnt vmcnt(0)" ::: "memory");
        } else {
            XB_SPIN(xb_ld(&bar[XB_XGEN(b.x)]) == gen, bar);
            __builtin_amdgcn_fence(__ATOMIC_ACQUIRE, "agent");
            asm volatile("s_waitcnt vmcnt(0)" ::: "memory");
        }
    }
    __syncthreads();
}

struct Args { const float* in[22]; float* out; unsigned char* ws; int ph_lo, ph_hi; };
static_assert(sizeof(Args) == 22 * 8 + 8 + 8 + 8, "no padding in Args");

struct CvtItem { const float* src; bf16* dst; int ldn, Kd, r0, r1; const float* gk; };
__device__ __forceinline__ void cvt_load(f32x4 (&r)[16], f32x2 (&gq)[8], const CvtItem& I, int lane, const float* gdummy) {
    const float* p = I.src + (size_t)(2 * (lane >> 4)) * I.ldn + 4 * (lane & 15);
#pragma unroll
    for (int i = 0; i < 8; ++i)
#pragma unroll
        for (int t = 0; t < 2; ++t) asm volatile("global_load_dwordx4 %0, %1, off nt" : "=&v"(r[2 * i + t]) : "v"(p + (size_t)(8 * i + t) * I.ldn) : "memory");
    const float* gp = (I.gk ? I.gk : gdummy) + 2 * (lane >> 4);
#pragma unroll
    for (int i = 0; i < 8; ++i) asm volatile("global_load_dwordx2 %0, %1, off" : "=&v"(gq[i]) : "v"(gp + 8 * i) : "memory");
}
__device__ __forceinline__ void cvt_proc(const f32x4 (&r)[16], const f32x2 (&gq)[8], const CvtItem& I, LAS unsigned* scr, int lane) {
    const int g = lane >> 4, nl = 4 * (lane & 15);
#pragma unroll
    for (int i = 0; i < 8; ++i)
#pragma unroll
        for (int c = 0; c < 4; ++c) { const float ga = I.gk ? gq[i][0] : 1.f, gb = I.gk ? gq[i][1] : 1.f; scr[(nl + c) * 33 + 4 * i + g] = pk2(r[2 * i][c] * ga, r[2 * i + 1][c] * gb); }
    LDS_WAIT(); asm volatile("" ::: "memory");
    const int c8 = lane & 7;
#pragma unroll
    for (int j = 0; j < 8; ++j) { const int n = 8 * j + (lane >> 3); const LAS unsigned* q = scr + n * 33 + 4 * c8;
        u32x4 o; o.x = q[0]; o.y = q[1]; o.z = q[2]; o.w = q[3];
        const int row = (n < 32 ? I.r0 + n : I.r1 + n - 32);
        *(u32x4*)(I.dst + (size_t)row * I.Kd + 8 * c8) = o; }
    LDS_WAIT(); asm volatile("" ::: "memory");
}
#define CVT_TOUCHG(R_, G_) do { _Pragma("unroll") for (int z_ = 0; z_ < 16; ++z_) asm volatile("" : "+v"(R_[z_])); _Pragma("unroll") for (int z_ = 0; z_ < 8; ++z_) asm volatile("" : "+v"(G_[z_])); } while (0)
#define CVT_RUN(NITEMS_, DEC, GDUMMY_) do { f32x4 ra_[16], rb_[16]; f32x2 ga_[8], gb_[8]; int it_ = gw; CvtItem Ia_, Ib_; \
    _Pragma("unroll") for (int z_ = 0; z_ < 16; ++z_) { ra_[z_] = (f32x4){0.f, 0.f, 0.f, 0.f}; rb_[z_] = ra_[z_]; } \
    _Pragma("unroll") for (int z_ = 0; z_ < 8; ++z_) { ga_[z_] = (f32x2){0.f, 0.f}; gb_[z_] = ga_[z_]; } Ia_ = DEC(0); Ib_ = Ia_; \
    if (it_ < (NITEMS_)) { Ia_ = DEC(it_); cvt_load(ra_, ga_, Ia_, lane, (GDUMMY_)); } \
    while (it_ < (NITEMS_)) { int it2_ = it_ + NGW; \
        if (it2_ < (NITEMS_)) { Ib_ = DEC(it2_); cvt_load(rb_, gb_, Ib_, lane, (GDUMMY_)); asm volatile("s_waitcnt vmcnt(24)" ::: "memory"); } else asm volatile("s_waitcnt vmcnt(0)" ::: "memory"); \
        CVT_TOUCHG(ra_, ga_); cvt_proc(ra_, ga_, Ia_, scr, lane); it_ = it2_; if (!(it_ < (NITEMS_))) break; \
        it2_ = it_ + NGW; if (it2_ < (NITEMS_)) { Ia_ = DEC(it2_); cvt_load(ra_, ga_, Ia_, lane, (GDUMMY_)); asm volatile("s_waitcnt vmcnt(24)" ::: "memory"); } else asm volatile("s_waitcnt vmcnt(0)" ::: "memory"); \
        CVT_TOUCHG(rb_, gb_); cvt_proc(rb_, gb_, Ib_, scr, lane); it_ = it2_; } } while (0)

struct CvtItem8 { const float* src; unsigned char* dst; int ldn, Kd, r0, r1; float scale; };
__device__ __forceinline__ void cvt_load4(f32x4 (&r)[16], const CvtItem8& I, int lane) {
    const float* p = I.src + (size_t)(4 * (lane >> 3)) * I.ldn + 4 * (lane & 7);
#pragma unroll
    for (int i = 0; i < 4; ++i)
#pragma unroll
        for (int t = 0; t < 4; ++t) asm volatile("global_load_dwordx4 %0, %1, off nt" : "=&v"(r[4 * i + t]) : "v"(p + (size_t)(32 * i + t) * I.ldn) : "memory");
}
__device__ __forceinline__ void cvt_proc8(const f32x4 (&r)[16], const CvtItem8& I, LAS unsigned* scr, int lane) {
    const int g = lane >> 3, nl = 4 * (lane & 7); const float sc = I.scale;
#pragma unroll
    for (int i = 0; i < 4; ++i)
#pragma unroll
        for (int c = 0; c < 4; ++c) scr[(nl + c) * 33 + 8 * i + g] = pg8::pk4_fp8(r[4 * i][c] * sc, r[4 * i + 1][c] * sc, r[4 * i + 2][c] * sc, r[4 * i + 3][c] * sc);
    LDS_WAIT(); asm volatile("" ::: "memory");
    const int c8 = lane & 7;
#pragma unroll
    for (int j = 0; j < 4; ++j) { const int n = 8 * j + (lane >> 3); const LAS unsigned* q = scr + n * 33 + 4 * c8;
        u32x4 o; o.x = q[0]; o.y = q[1]; o.z = q[2]; o.w = q[3];
        *(u32x4*)(I.dst + (size_t)(I.r0 + n) * I.Kd + 16 * c8) = o; }
    LDS_WAIT(); asm volatile("" ::: "memory");
}
#define CVT_TOUCH(R_) do { _Pragma("unroll") for (int z_ = 0; z_ < 16; ++z_) asm volatile("" : "+v"(R_[z_])); } while (0)
#define CVT_RUN8(NITEMS_, DEC) do { f32x4 ra_[16], rb_[16]; int it_ = gw; CvtItem8 Ia_, Ib_; \
    _Pragma("unroll") for (int z_ = 0; z_ < 16; ++z_) { ra_[z_] = (f32x4){0.f, 0.f, 0.f, 0.f}; rb_[z_] = ra_[z_]; } Ia_ = DEC(0); Ib_ = Ia_; \
    if (it_ < (NITEMS_)) { Ia_ = DEC(it_); cvt_load4(ra_, Ia_, lane); } \
    while (it_ < (NITEMS_)) { int it2_ = it_ + NGW; \
        if (it2_ < (NITEMS_)) { Ib_ = DEC(it2_); cvt_load4(rb_, Ib_, lane); asm volatile("s_waitcnt vmcnt(16)" ::: "memory"); } else asm volatile("s_waitcnt vmcnt(0)" ::: "memory"); \
        CVT_TOUCH(ra_); cvt_proc8(ra_, Ia_, scr, lane); it_ = it2_; if (!(it_ < (NITEMS_))) break; \
        it2_ = it_ + NGW; if (it2_ < (NITEMS_)) { Ia_ = DEC(it2_); cvt_load4(ra_, Ia_, lane); asm volatile("s_waitcnt vmcnt(16)" ::: "memory"); } else asm volatile("s_waitcnt vmcnt(0)" ::: "memory"); \
        CVT_TOUCH(rb_); cvt_proc8(rb_, Ib_, scr, lane); it_ = it2_; } } while (0)

__device__ __forceinline__ void rms_row_to_bf16(const float* xrow, const float* g, bf16* orow, int lane, f32x4 (&v)[4]) {
    const f32x4* xr = (const f32x4*)xrow + lane; float s = 0.f;
#pragma unroll
    for (int j = 0; j < 4; ++j) { v[j] = xr[64 * j]; s += (v[j][0] * v[j][0] + v[j][1] * v[j][1]) + (v[j][2] * v[j][2] + v[j][3] * v[j][3]); }
    const float r = 1.0f / sqrtf(wave_sum(s) * (1.f / D) + EPS);
    unsigned long long* o8 = (unsigned long long*)orow + lane;
#pragma unroll
    for (int j = 0; j < 4; ++j) { const f32x4 gg = ((const f32x4*)g)[lane + 64 * j]; v[j] = v[j] * r * gg;
        o8[64 * j] = (unsigned long long)pk2(v[j][0], v[j][1]) | ((unsigned long long)pk2(v[j][2], v[j][3]) << 32); }
}

__global__ void __launch_bounds__(NWAVES * 64, 2) fwd_kernel(Args args) {
    extern __shared__ __attribute__((aligned(16))) unsigned char lds_raw[];
    LAS unsigned char* lds = (LAS unsigned char*)lds_raw;
    volatile LAS unsigned* MISC = (volatile LAS unsigned*)(lds + MISC_OFF);
    int tid = threadIdx.x, lane = tid & 63; const int wave = __builtin_amdgcn_readfirstlane(tid >> 6);
    const int G = gridDim.x, blk = blockIdx.x;
    unsigned char* ws = args.ws;
    unsigned* ctl = (unsigned*)(ws + WS_CTL);
    for (int u = tid; u < (LDS_BYTES - LDSCTL_OFF) / 4; u += NWAVES * 64) ((LAS unsigned*)(lds + LDSCTL_OFF))[u] = 0u;
    __syncthreads();
    XcdBarrier bar = xcd_barrier_post(ctl + CW_BAR, MISC + 8);

    const float* x_in = args.in[0];
    float* xs = args.out;
    unsigned char* wsq = ws;
#define XN ((bf16*)(wsq + WS_XN))
#define QKV ((bf16*)(wsq + WS_QKV))
#define PARTA ((bf16*)(wsq + WS_PARTA))
#define PARTB ((bf16*)(wsq + WS_PARTB))
#define LA ((float*)(wsq + WS_LA))
#define LB ((float*)(wsq + WS_LB))
#define RLUT ((float*)(wsq + WS_LUT))
#define SCAL ((float*)(wsq + WS_SCAL))
#define HIST ((int*)(wsq + WS_HIST))
#define META ((int*)(wsq + WS_META))
#define TOKE ((int*)(wsq + WS_TOKE))
#define TOKG ((float*)(wsq + WS_TOKG))
#define PSLOT ((int*)(wsq + WS_PSLOT))
#define ROWTOK ((int*)(wsq + WS_ROWTOK))
    const int gw = blk * NWAVES + wave, NGW = G * NWAVES;

    const int lo = args.ph_lo, hi_ph = args.ph_hi; int pc = 0;
#define PH_ON (tid = opq(threadIdx.x), lane = tid & 63, wsq = opq_p(args.ws), pc >= lo && pc < hi_ph)
#ifdef PROBE_DUP
#define NREP(k, extra) ((PROBE_DUP == (k) && (extra)) ? 2 : 1)
#else
#define NREP(k, extra) 1
#endif
#define PH_REP(k, extra) for (int rep_ = 0; rep_ < NREP(k, extra); ++rep_, (rep_ < NREP(k, extra) ? xcd_barrier(bar) : (void)0))
#define PH_END do { if (pc >= lo && pc + 1 < hi_ph) xcd_barrier(bar); ++pc; } while (0)

    if (PH_ON) PH_REP(0, true) {
        LAS unsigned* scr = (LAS unsigned*)(lds + wave * 16384);
        constexpr int I_IN = 16 * 48, I_OUT = 16 * 16, I_GD = 16 * 44, I_DD = 44 * 16;
        constexpr int NITEMS = 2 * I_IN + 2 * I_OUT + 2 * I_GD + I_DD;
        auto dec0 = [&](int it) -> CvtItem { CvtItem I; int r = it;
            if (r < 2 * I_IN) { const int l = r / I_IN; r %= I_IN; const int kb = r / 48, nb = 2 * (r % 48), tile = nb >> 3, ob = nb & 7;
                I.src = args.in[3] + (size_t)l * D * PROJ + (size_t)(64 * kb) * PROJ + 32 * nb; I.ldn = PROJ; I.dst = (bf16*)(wsq + WS_WIN) + (size_t)l * PROJ * D + 64 * kb; I.Kd = D;
                I.r0 = tile * 256 + (ob >> 1) * 32; I.r1 = I.r0 + 128; I.gk = args.in[1] + l * D + 64 * kb; return I; }
            r -= 2 * I_IN;
            if (r < 2 * I_OUT) { const int l = r / I_OUT; r %= I_OUT; const int kb = r / 16, nb = r % 16;
                I.src = args.in[4] + (size_t)l * D * D + (size_t)(64 * kb) * D + 64 * nb; I.ldn = D; I.dst = (bf16*)(wsq + WS_WOUT) + (size_t)l * D * D + 64 * kb; I.Kd = D; I.r0 = 64 * nb; I.r1 = I.r0 + 32; I.gk = nullptr; return I; }
            r -= 2 * I_OUT;
            if (r < 2 * I_GD) { const int up = r / I_GD; r %= I_GD; const int kb = r / 44, nb = r % 44;
                I.src = args.in[15 + up] + (size_t)(64 * kb) * DFF + 64 * nb; I.ldn = DFF; I.dst = (bf16*)(wsq + WS_WGUD) + 64 * kb; I.Kd = D; I.r0 = (nb >> 1) * 256 + up * 128 + (nb & 1) * 64; I.r1 = I.r0 + 32; I.gk = args.in[2] + 64 * kb; return I; }
            r -= 2 * I_GD;
            { const int kb = r / 16, nb = r % 16; I.src = args.in[17] + (size_t)(64 * kb) * D + 64 * nb; I.ldn = D; I.dst = (bf16*)(wsq + WS_WDND) + 64 * kb; I.Kd = DFF; I.r0 = 64 * nb; I.r1 = I.r0 + 32; I.gk = nullptr; return I; } };
        CVT_RUN(NITEMS, dec0, args.in[1]);
        __syncthreads();
        LAS unsigned* red = (LAS unsigned*)(lds);
        if (tid < 2) red[tid] = 0u;
        __syncthreads();
        { float gm = 0.f, bm = 0.f;
          for (int i = tid; i < 4 * 2 * 64; i += NWAVES * 64) gm = fmaxf(gm, fabsf(args.in[5 + (i >> 7)][i & 127]));
          for (int i = tid; i < 32 * 12; i += NWAVES * 64) bm = fmaxf(bm, fabsf(args.in[14][i]));
          atomicMax((unsigned*)&red[0], __float_as_uint(gm)); atomicMax((unsigned*)&red[1], __float_as_uint(bm)); }
        __syncthreads();
        const float gmax = __uint_as_float(red[0]), bmax = __uint_as_float(red[1]);
        const float M2 = (8.f * gmax * gmax * 1.01f + bmax + 0.5f) * LOG2E;
        for (int e = blk * (NWAVES * 64) + tid; e < 28 * att::LUTN; e += G * NWAVES * 64) {
            const int id = e / att::LUTN, j = e % att::LUTN, s = (383 - j) - 128;
            float v = -INFINITY;
            if (id < 24) { const int br = id >> 3, h = id & 7, dil = br == 0 ? 1 : br == 1 ? 4 : 16;
                if (s >= 0 && s <= 128) { const int dist = s * dil; v = args.in[14][t5_bucket(dist < 128 ? dist : 128) * 12 + h] * LOG2E - M2; } }
            else { const int h = id - 24; if (s >= 0) v = args.in[14][t5_bucket(s < 128 ? s : 128) * 12 + 8 + h] * LOG2E - M2; }
            RLUT[e] = v;
        }
        if (blk == 0 && wave < 2) { const int l = wave;
            const float d1 = wave_sum(args.in[9][l * 64 + lane] * args.in[10][l * 64 + lane]), d2 = wave_sum(args.in[11][l * 64 + lane] * args.in[12][l * 64 + lane]);
            const float lam_init = 0.8f - 0.6f * expf(-0.3f * (float)l);
            if (lane == 0) { SCAL[l * 4 + 0] = expf(d1) - expf(d2) + lam_init; SCAL[l * 4 + 1] = 1.f - lam_init; } }
        for (int i = blk * (NWAVES * 64) + tid; i < MAXTILES * 256; i += G * NWAVES * 64) ROWTOK[i] = 0;
        { bf16* XB0 = (bf16*)(wsq + WS_XB); float* RSS0 = (float*)(wsq + WS_RSS);
          for (int m = gw; m < NT; m += 4 * NGW) { f32x4 v[4][4];
#pragma unroll
              for (int q = 0; q < 4; ++q) { const f32x4* xr = (const f32x4*)(x_in + (size_t)min(m + q * NGW, NT - 1) * D) + lane;
#pragma unroll
                  for (int j = 0; j < 4; ++j) v[q][j] = __builtin_nontemporal_load(xr + 64 * j); }
#pragma unroll
              for (int q = 0; q < 4; ++q) { if (m + q * NGW >= NT) break; float ss = 0.f;
#pragma unroll
                  for (int j = 0; j < 4; ++j) ss += (v[q][j][0] * v[q][j][0] + v[q][j][1] * v[q][j][1]) + (v[q][j][2] * v[q][j][2] + v[q][j][3] * v[q][j][3]);
                  ss = wave_sum(ss);
                  if (lane < 16) RSS0[(size_t)(m + q * NGW) * 16 + lane] = lane == 0 ? ss : 0.f;
                  unsigned long long* o8 = (unsigned long long*)(XB0 + (size_t)(m + q * NGW) * D) + lane;
#pragma unroll
                  for (int j = 0; j < 4; ++j) { const f32x4 t = v[q][j];
                      o8[64 * j] = (unsigned long long)pk2(t[0], t[1]) | ((unsigned long long)pk2(t[2], t[3]) << 32); } } } }
    }
    PH_END;

#pragma nounroll
    for (int layer = 0; layer < 2; ++layer) {
        if (PH_ON) PH_REP(1, true) {
            pg8::Gemm g{(const bf16*)(wsq + WS_XB), (const bf16*)(wsq + WS_WIN) + (size_t)layer * PROJ * D, D, nullptr};
            pg8::StaticOrder S; S.init(NT, PROJ, G, blk);
            pg8::EpiQKV E{QKV, {args.in[5] + layer * 64, args.in[6] + layer * 64, args.in[7] + layer * 64, args.in[8] + layer * 64}, (const float*)(wsq + WS_RSS)};

#ifndef SKIP_QKV
            pg8::gemm_phase<pg8::EpiQKV, pg8::StaticOrder, false>(lds, g, S, E);
#endif

        }
        PH_END;
        if (PH_ON) PH_REP(2, true) {
            const int hsel = wave >> 2;
            const float lam_l = SCAL[layer * 4 + 0], oml_l = SCAL[layer * 4 + 1];
            for (int rb_ = 0; rb_ < NREP(20, true); ++rb_)
            for (int u = blk; u < 1024; u += G) {
                const int c = u & 255, i = u >> 8, idx = c >> 3, bh = (c & 7) * 8 + (idx >> 2), qq = idx & 3, n = i == 0 ? qq : i == 1 ? 7 - qq : i == 2 ? 8 + qq : 15 - qq;
                const int b = bh >> 2, h = bh & 3, vh = 2 * h + hsel;
                att::Job J; J.b = b; J.dil = 1; J.rho = 0; J.U0 = 128 * n; J.kt_lo = 0; J.kt_hi = 2 * n + 2;
                J.qG = 24 + vh; J.kG = 32 + vh; J.vG = 40 + 2 * h + hsel; J.lutid = 24 + h;
                J.O = XN; J.opitch = 1024; J.ooff = 512 + h * 128; J.L = nullptr; J.lpitch = 0; J.loff = 0; J.lam = lam_l; J.oml = oml_l; J.sg = args.in[13] + layer * 128;

#ifndef SKIP_ATTB
                att::unit<128, false>(lds, QKV, RLUT, J);
#endif

            }
            for (int ra_ = 0; ra_ < NREP(21, true); ++ra_)
            for (int u = blk; u < 256; u += G) {
                const int hp = u & 3, b = (u >> 2) & 15, q = u >> 6;
                att::unit_a12(lds, QKV, RLUT, PARTA, LA, b, hp, q);
            }
            __syncthreads();
        }
        PH_END;
        if (PH_ON) PH_REP(3, true) {
            for (int t = gw; t < NT; t += NGW) {
                const int h = lane >> 3; float acc[8]; float l = 0.f;
#pragma unroll
                for (int k = 0; k < 8; ++k) acc[k] = 0.f;
#pragma unroll
                for (int br = 0; br < 3; ++br) {
                    const u32x4 a = *(const u32x4*)(PARTA + ((size_t)br * NT + t) * 512 + lane * 8);
                    const unsigned w[4] = {a.x, a.y, a.z, a.w};
#pragma unroll
                    for (int k = 0; k < 4; ++k) { acc[2 * k] += bflo(w[k]); acc[2 * k + 1] += bfhi(w[k]); }
                    l += LA[((size_t)br * NT + t) * 8 + h];
                }
                const float rl = 1.f / l;
                *(u32x4*)(XN + (size_t)t * D + lane * 8) = (u32x4){pk2(acc[0] * rl, acc[1] * rl), pk2(acc[2] * rl, acc[3] * rl), pk2(acc[4] * rl, acc[5] * rl), pk2(acc[6] * rl, acc[7] * rl)};
            }
        }
        PH_END;
        if (PH_ON) PH_REP(4, layer == 0) {
            pg8::Gemm g{XN, (const bf16*)(wsq + WS_WOUT) + (size_t)layer * D * D, D, nullptr};
            pg8::StaticOrder S; S.init(NT, D, G, blk);
            pg8::EpiResN E{nullptr, (const bf16*)(wsq + WS_XB), nullptr, layer == 0 ? (bf16*)(wsq + WS_XR2) : (bf16*)xs, layer == 0 ? (float*)(wsq + WS_RSS) : nullptr, layer == 0 ? D : 2 * D};

#ifndef SKIP_RES
                pg8::gemm_phase<pg8::EpiResN, pg8::StaticOrder, false>(lds, g, S, E);
#endif

        }
        PH_END;
        if (layer == 1) {
        if (PH_ON) PH_REP(6, true) {
            const float* gf = args.in[2] + layer * D;
            {
                LAS float* wr_l = (LAS float*)(lds);
                LAS int* hist = (LAS int*)(lds + 32768);
                LAS float* wsum = (LAS float*)(lds + 32768 + 64);
                LAS float* gl_l = (LAS float*)(lds + 36864);
                { constexpr int TOT = NEXP * D * DFFE, STRIDE = 7151;
                  float sv[3][8];
#pragma unroll
                  for (int ts = 0; ts < 3; ++ts)
#pragma unroll
                      for (int q = 0; q < 8; ++q) asm volatile("global_load_dword %0, %1, off" : "=&v"(sv[ts][q]) : "v"(args.in[19 + ts] + (size_t)(tid * 8 + q) * STRIDE) : "memory");
                  static_assert((size_t)4095 * STRIDE < (size_t)TOT, "sample inside the tensor");
                  asm volatile("s_waitcnt vmcnt(0)" ::: "memory");
#pragma unroll
                  for (int ts = 0; ts < 3; ++ts) { float a = 0.f;
#pragma unroll
                      for (int q = 0; q < 8; ++q) { asm volatile("" : "+v"(sv[ts][q])); a += fabsf(sv[ts][q]); }
                      a = wave_sum(a); if (lane == 0) wsum[ts * 8 + wave] = a; } }
                { f32x4 wv[4];
#pragma unroll
                  for (int u = 0; u < 4; ++u) { const int i = tid + u * (NWAVES * 64), c = i >> 1, half = i & 1; wv[u] = *(const f32x4*)(args.in[18] + c * 8 + half * 4); }
                  if (tid < 256) *(LAS f32x4*)(gl_l + tid * 4) = *(const f32x4*)(gf + tid * 4);
#pragma unroll
                  for (int u = 0; u < 4; ++u) { const int i = tid + u * (NWAVES * 64), c = i >> 1, half = i & 1, ln = (c & 255) >> 2, q = c & 3, j = c >> 8;
                    *(LAS f32x4*)(wr_l + half * 4096 + ((j * 4 + q) * 64 + ln) * 4) = wv[u]; } }
                __syncthreads();
                float wscale[3];
#pragma unroll
                for (int ts = 0; ts < 3; ++ts) { float a = 0.f;
#pragma unroll
                    for (int w8 = 0; w8 < 8; ++w8) a += wsum[ts * 8 + w8];
                    const float sigma = a * (1.f / 4096.f) * 1.2533141f;
                    wscale[ts] = exp2f(rintf(log2f(8.f / fmaxf(sigma, 1e-30f)))); }
                if (blk == 0 && tid == 0) { SCAL[8] = 1.f / (8.f * wscale[0]); SCAL[9] = 1.f / (8.f * wscale[1]); SCAL[10] = 1.f / (8.f * wscale[2]); }
                unsigned char* XN8 = wsq + WS_XN8;
                LAS unsigned* scr = (LAS unsigned*)(lds + 40960 + wave * 4352);
                constexpr int I_G = 8 * 112, I_D = 28 * 32, PER_E = 2 * I_G + I_D, NIT = NEXP * PER_E;
                auto dec1 = [&](int it) -> CvtItem8 { CvtItem8 I; const int e = it / PER_E; int r = it % PER_E;
                    if (r < 2 * I_G) { const int up = r / I_G; r %= I_G; const int kb = r / 112, nb = r % 112;
                        I.src = args.in[19 + up] + (size_t)e * D * DFFE + (size_t)(128 * kb) * DFFE + 32 * nb; I.ldn = DFFE; I.dst = wsq + WS_WGUM + (size_t)e * 2 * DFFE * D + 128 * kb; I.Kd = D;
                        I.r0 = (nb >> 2) * 256 + up * 128 + (nb & 3) * 32; I.r1 = 0; I.scale = up ? wscale[1] : wscale[0]; return I; }
                    r -= 2 * I_G; const int kb = r / 32, nb = r % 32;
                    I.src = args.in[21] + (size_t)e * DFFE * D + (size_t)(128 * kb) * D + 32 * nb; I.ldn = D; I.dst = wsq + WS_WDNM + (size_t)e * D * DFFE + 128 * kb; I.Kd = DFFE; I.r0 = 32 * nb; I.r1 = 0; I.scale = wscale[2]; return I; };
                int cit = gw; bool pend = false; CvtItem8 Ic = dec1(0); f32x4 cr_[16];
#pragma unroll
                for (int z_ = 0; z_ < 16; ++z_) cr_[z_] = (f32x4){0.f, 0.f, 0.f, 0.f};
                for (int c = blk; c < 256; c += G) {
                    __syncthreads();
                    if (tid < 8) hist[tid] = 0;
                    __syncthreads();
                    u32x2 nx[4];
                    { const u32x2* xr = (const u32x2*)((const bf16*)xs + (size_t)(c * 128 + wave * 16) * (2 * D)) + lane;
#pragma unroll
                      for (int j = 0; j < 4; ++j) asm volatile("global_load_dwordx2 %0, %1, off" : "=&v"(nx[j]) : "v"(xr + 64 * j) : "memory");
                      asm volatile("s_waitcnt vmcnt(0)" ::: "memory"); }
                    int re0 = 0, re1 = 0; float rg0 = 0.f, rg1 = 0.f;
                    for (int k = 0; k < 16; ++k) {
                        if (pend) { CVT_TOUCH(cr_); cvt_proc8(cr_, Ic, scr, lane); pend = false; }
                        const int m = c * 128 + wave * 16 + k; f32x4 v[4];
#pragma unroll
                        for (int j = 0; j < 4; ++j) { asm volatile("" : "+v"(nx[j])); v[j] = (f32x4){bflo(nx[j].x), bfhi(nx[j].x), bflo(nx[j].y), bfhi(nx[j].y)}; }
                        { const u32x2* xr = (const u32x2*)((const bf16*)xs + (size_t)(k + 1 < 16 ? m + 1 : m) * (2 * D)) + lane;
#pragma unroll
                            for (int j = 0; j < 4; ++j) asm volatile("global_load_dwordx2 %0, %1, off" : "=&v"(nx[j]) : "v"(xr + 64 * j) : "memory"); }
                        if (cit < NIT) { Ic = dec1(cit); cvt_load4(cr_, Ic, lane); cit += NGW; pend = true; }
                        { float sq = 0.f;
#pragma unroll
                          for (int j = 0; j < 4; ++j) sq += (v[j][0] * v[j][0] + v[j][1] * v[j][1]) + (v[j][2] * v[j][2] + v[j][3] * v[j][3]);
                          const float r = 1.0f / sqrtf(wave_sum(sq) * (1.f / D) + EPS);
#pragma unroll
                          for (int j = 0; j < 4; ++j) { const f32x4 gg = *(const LAS f32x4*)(gl_l + (lane + 64 * j) * 4); v[j] = v[j] * r * gg;
                              *(unsigned*)(XN8 + (size_t)m * D + 4 * lane + 256 * j) = pg8::pk4_fp8(8.f * v[j][0], 8.f * v[j][1], 8.f * v[j][2], 8.f * v[j][3]); } }
                        float lg[8];
#pragma unroll
                        for (int e = 0; e < 8; ++e) lg[e] = 0.f;
#pragma unroll
                        for (int j = 0; j < 4; ++j)
#pragma unroll
                            for (int q = 0; q < 4; ++q) { const f32x4 w0 = *(const LAS f32x4*)(wr_l + ((j * 4 + q) * 64 + lane) * 4), w1 = *(const LAS f32x4*)(wr_l + 4096 + ((j * 4 + q) * 64 + lane) * 4); const float xv = v[j][q];
                                lg[0] += xv * w0[0]; lg[1] += xv * w0[1]; lg[2] += xv * w0[2]; lg[3] += xv * w0[3]; lg[4] += xv * w1[0]; lg[5] += xv * w1[1]; lg[6] += xv * w1[2]; lg[7] += xv * w1[3]; }
                        { const bool b5 = lane & 32, b4 = lane & 16, b3 = lane & 8; float a4[4], a2[2], a1;
#pragma unroll
                          for (int i = 0; i < 4; ++i) { const float keep = b5 ? lg[4 + i] : lg[i], send = b5 ? lg[i] : lg[4 + i]; a4[i] = keep + __shfl_xor(send, 32); }
#pragma unroll
                          for (int i = 0; i < 2; ++i) { const float keep = b4 ? a4[2 + i] : a4[i], send = b4 ? a4[i] : a4[2 + i]; a2[i] = keep + __shfl_xor(send, 16); }
                          { const float keep = b3 ? a2[1] : a2[0], send = b3 ? a2[0] : a2[1]; a1 = keep + __shfl_xor(send, 8); }
                          a1 += __shfl_xor(a1, 4); a1 += __shfl_xor(a1, 2); a1 += __shfl_xor(a1, 1);
#pragma unroll
                          for (int e = 0; e < 8; ++e) lg[e] = __int_as_float(__builtin_amdgcn_readlane(__float_as_int(a1), ((e >> 2) & 1) * 32 + ((e >> 1) & 1) * 16 + (e & 1) * 8)); }
                        int e0 = 0; float v0 = lg[0];
#pragma unroll
                        for (int e = 1; e < 8; ++e) if (lg[e] > v0) { v0 = lg[e]; e0 = e; }
                        int e1 = -1; float v1 = -INFINITY;
#pragma unroll
                        for (int e = 0; e < 8; ++e) if (e != e0 && lg[e] > v1) { v1 = lg[e]; e1 = e; }
                        { const float g1 = 1.f / (1.f + expf(v0 - v1)), g0 = 1.f - g1;
                          const bool mine = lane == k; re0 = mine ? e0 : re0; re1 = mine ? e1 : re1; rg0 = mine ? g0 : rg0; rg1 = mine ? g1 : rg1; }
                        asm volatile("s_waitcnt vmcnt(4)" ::: "memory");
                    }
                    if (pend) { CVT_TOUCH(cr_); cvt_proc8(cr_, Ic, scr, lane); pend = false; }
                    if (lane < 16) { const int m = c * 128 + wave * 16 + lane;
                        TOKE[2 * m] = re0; TOKE[2 * m + 1] = re1; TOKG[2 * m] = rg0; TOKG[2 * m + 1] = rg1;
                        atomicAdd((int*)&hist[re0], 1); atomicAdd((int*)&hist[re1], 1); }
                    __syncthreads();
                    if (tid < 8) HIST[c * 8 + tid] = hist[tid];
                }
                while (cit < NIT) { Ic = dec1(cit); cvt_load4(cr_, Ic, lane); cit += NGW; asm volatile("s_waitcnt vmcnt(0)" ::: "memory"); CVT_TOUCH(cr_); cvt_proc8(cr_, Ic, scr, lane); }
            }
        }
        PH_END;
        }
        if (layer == 0) {
            if (PH_ON) PH_REP(7, true) {
                pg8::Gemm g{(const bf16*)(wsq + WS_XR2), (const bf16*)(wsq + WS_WGUD), D, nullptr};
                pg8::StaticOrder S; S.init(NT, 2 * DFF, G, blk);
                pg8::EpiSwiGLU E{(bf16*)(wsq + WS_HID), DFF, 0, (const float*)(wsq + WS_RSS)};

#ifndef SKIP_GUD
                pg8::gemm_phase<pg8::EpiSwiGLU, pg8::StaticOrder, false>(lds, g, S, E);
#endif

            }
            PH_END;
            if (PH_ON) {
                pg8::Gemm g{(const bf16*)(wsq + WS_HID), (const bf16*)(wsq + WS_WDND), DFF, nullptr};
                pg8::StaticOrder S; S.init(NT, D, G, blk);
                pg8::EpiResN E{nullptr, (const bf16*)(wsq + WS_XR2), nullptr, (bf16*)(wsq + WS_XB), (float*)(wsq + WS_RSS), D};

#ifndef SKIP_RES
                pg8::gemm_phase<pg8::EpiResN, pg8::StaticOrder, false>(lds, g, S, E);
#endif

            }
            PH_END;
        } else {
            if (PH_ON) {
                LAS int* H = (LAS int*)lds;
                LAS int* tot = (LAS int*)(lds + 8192);
                LAS int* pre = (LAS int*)(lds + 8192 + 64);
                { int hv[4];
#pragma unroll
                  for (int u = 0; u < 4; ++u) hv[u] = HIST[tid + u * (NWAVES * 64)];
#pragma unroll
                  for (int u = 0; u < 4; ++u) H[tid + u * (NWAVES * 64)] = hv[u]; }
                __syncthreads();
                { const int e = wave;
                  const int h0 = H[(4 * lane) * 8 + e], h1 = H[(4 * lane + 1) * 8 + e], h2 = H[(4 * lane + 2) * 8 + e], h3 = H[(4 * lane + 3) * 8 + e];
                  const int s = h0 + h1 + h2 + h3; int inc = s;
#pragma unroll
                  for (int o = 1; o < 64; o <<= 1) { const int t = __shfl_up(inc, o); if (lane >= o) inc += t; }
                  const int ex = inc - s;
                  pre[(4 * lane) * 8 + e] = ex; pre[(4 * lane + 1) * 8 + e] = ex + h0; pre[(4 * lane + 2) * 8 + e] = ex + h0 + h1; pre[(4 * lane + 3) * 8 + e] = ex + h0 + h1 + h2;
                  if (lane == 63) tot[e] = inc; }
                __syncthreads();
                int tstart[8]; { int acc = 0;
#pragma unroll
                  for (int e = 0; e < 8; ++e) { tstart[e] = acc; acc += (tot[e] + 255) >> 8; }
                  if (blk == 0 && tid == 0) { int a2 = 0; for (int e = 0; e < 8; ++e) { a2 += (tot[e] + 255) >> 8; META[e] = a2; } META[8] = a2; } }
                if (wave == 0) {
                    for (int c = blk; c < 256; c += G) {
                        int run[8];
#pragma unroll
                        for (int e = 0; e < 8; ++e) run[e] = tstart[e] * 256 + pre[c * 8 + e];
                        int pev[4];
#pragma unroll
                        for (int rd = 0; rd < 4; ++rd) pev[rd] = TOKE[c * 256 + rd * 64 + lane];
#pragma unroll
                        for (int rd = 0; rd < 4; ++rd) {
                            const int p = c * 256 + rd * 64 + lane;
                            const int pe = pev[rd]; int slot = 0;
#pragma unroll
                            for (int e = 0; e < 8; ++e) { const unsigned long long mk = __ballot(pe == e);
                                if (pe == e) slot = run[e] + __popcll(mk & ((1ull << lane) - 1ull));
                                run[e] += __popcll(mk); }
                            ROWTOK[slot] = p >> 1; PSLOT[p] = slot;
                        }
                    }
                }
            }
            PH_END;
            int te[8]; int ntiles;
            for (int r = 0; r < NROUNDS; ++r) {
                if (PH_ON) PH_REP(10, true) {
                    { const int mv = __hip_atomic_load(META + (lane < 9 ? lane : 8), __ATOMIC_RELAXED, __HIP_MEMORY_SCOPE_AGENT);
#pragma unroll
                      for (int e = 0; e < 8; ++e) te[e] = __builtin_amdgcn_readlane(mv, e);
                      ntiles = __builtin_amdgcn_readlane(mv, 8); }
                    const int ntr = ntiles - r * RT < RT ? ntiles - r * RT : RT;
                    if (ntr > 0) {
                        pg8::Gemm g{(const bf16*)(wsq + WS_XN8), (const bf16*)(wsq + WS_WGUM), D / 2, ROWTOK};
                        pg8::MoeOrder S; S.so.init(ntr * 256, 2 * DFFE, G, blk); S.pm0 = r * RT;
#pragma unroll
                        for (int e = 0; e < 8; ++e) S.te[e] = te[e];
                        pg8::EpiSwiGLU8 E{wsq + WS_HIDM, DFFE, SCAL[8], SCAL[9]};
#ifndef SKIP_GUM
                        pg8::gemm_phase<pg8::EpiSwiGLU8, pg8::MoeOrder, true, true>(lds, g, S, E);
#endif

                    }
                }
                PH_END;
                if (PH_ON) PH_REP(11, true) {
                    { const int mv = __hip_atomic_load(META + (lane < 9 ? lane : 8), __ATOMIC_RELAXED, __HIP_MEMORY_SCOPE_AGENT);
#pragma unroll
                      for (int e = 0; e < 8; ++e) te[e] = __builtin_amdgcn_readlane(mv, e);
                      ntiles = __builtin_amdgcn_readlane(mv, 8); }
                    const int ntr = ntiles - r * RT < RT ? ntiles - r * RT : RT;
                    if (ntr > 0) {
                        pg8::Gemm g{(const bf16*)(wsq + WS_HIDM), (const bf16*)(wsq + WS_WDNM), DFFE / 2, nullptr};
                        pg8::MoeOrder S; S.so.init(ntr * 256, D, G, blk); S.pm0 = r * RT;
#pragma unroll
                        for (int e = 0; e < 8; ++e) S.te[e] = te[e];
                        pg8::EpiBfS E{(bf16*)(wsq + WS_YPAD), SCAL[10]};
#ifndef SKIP_DNM
                        pg8::gemm_phase<pg8::EpiBfS, pg8::MoeOrder, false, true>(lds, g, S, E);
#endif

                    }
                }
                PH_END;
            }
            if (PH_ON) {
                const bf16* Y = (const bf16*)(wsq + WS_YPAD);
                int t = gw;
                u32x2 hn[4], an[4], bn[4]; float g0n = 0.f, g1n = 0.f;
#pragma unroll
                for (int j = 0; j < 4; ++j) { hn[j] = (u32x2){0u, 0u}; an[j] = hn[j]; bn[j] = hn[j]; }
#define FIN_LOAD(tt) do { const int s0_ = PSLOT[2 * (tt)], s1_ = PSLOT[2 * (tt) + 1]; g0n = TOKG[2 * (tt)]; g1n = TOKG[2 * (tt) + 1]; \
                    const u32x2* h_ = (const u32x2*)((const bf16*)xs + (size_t)(tt) * (2 * D)) + lane; \
                    const u32x2* y0_ = (const u32x2*)(Y + (size_t)s0_ * D) + lane; const u32x2* y1_ = (const u32x2*)(Y + (size_t)s1_ * D) + lane; \
                    _Pragma("unroll") for (int j = 0; j < 4; ++j) { hn[j] = h_[64 * j]; an[j] = y0_[64 * j]; bn[j] = y1_[64 * j]; } } while (0)
                if (t < NT) FIN_LOAD(t);
                while (t < NT) {
                    u32x2 hc[4], ac[4], bc[4]; const float g0 = g0n, g1 = g1n;
#pragma unroll
                    for (int j = 0; j < 4; ++j) { hc[j] = hn[j]; ac[j] = an[j]; bc[j] = bn[j]; }
                    const int t2 = t + NGW;
                    if (t2 < NT) FIN_LOAD(t2);
                    f32x4* xr = (f32x4*)(xs + (size_t)t * D) + lane;
#pragma unroll
                    for (int j = 0; j < 4; ++j) { f32x4 v;
                        v[0] = bflo(hc[j].x) + (g0 * bflo(ac[j].x) + g1 * bflo(bc[j].x)); v[1] = bfhi(hc[j].x) + (g0 * bfhi(ac[j].x) + g1 * bfhi(bc[j].x));
                        v[2] = bflo(hc[j].y) + (g0 * bflo(ac[j].y) + g1 * bflo(bc[j].y)); v[3] = bfhi(hc[j].y) + (g0 * bfhi(ac[j].y) + g1 * bfhi(bc[j].y));
                        xr[64 * j] = v; }
                    t = t2;
                }
#undef FIN_LOAD
            }
            PH_END;
        }
    }
#undef XN
#undef QKV
#undef PARTA
#undef PARTB
#undef LA
#undef LB
#undef RLUT
#undef SCAL
#undef HIST
#undef META
#undef TOKE
#undef TOKG
#undef PSLOT
#undef ROWTOK
#undef PH_ON
#undef PH_END
}

#ifndef MK_MULTI
#define MK_MULTI 0
#endif
extern "C" void kernel_launch(void* const* d_in, const int* in_sizes, int n_in, void* d_out, int out_size, void* d_ws, size_t ws_size, hipStream_t stream) {
    static int grid = 0;
    if (grid == 0) {
        if (n_in != 22 || out_size != NT * D || ws_size < WS_END) { fprintf(stderr, "kernel_launch: unexpected shapes (n_in %d, out %d, ws %zu)\n", n_in, out_size, ws_size); grid = -1; return; }
        int dev = 0, cus = 0, per_cu = 0;
        if (hipGetDevice(&dev) != hipSuccess || hipDeviceGetAttribute(&cus, hipDeviceAttributeMultiprocessorCount, dev) != hipSuccess) { grid = -1; return; }
        if (hipFuncSetAttribute((const void*)fwd_kernel, hipFuncAttributeMaxDynamicSharedMemorySize, LDS_BYTES) != hipSuccess) { fprintf(stderr, "kernel_launch: hipFuncSetAttribute failed\n"); grid = -1; return; }
        if (hipOccupancyMaxActiveBlocksPerMultiprocessor(&per_cu, (const void*)fwd_kernel, NWAVES * 64, LDS_BYTES) != hipSuccess || per_cu < 1) fprintf(stderr, "kernel_launch: occupancy query reports %d\n", per_cu);
        (void)hipGetLastError();
        grid = cus;
    }
    if (grid < 0) return;
    if (hipMemsetAsync((char*)d_ws + WS_CTL, 0, CTL_ZERO_BYTES, stream) != hipSuccess) return;
    Args a{};
    for (int i = 0; i < 22; ++i) a.in[i] = (const float*)d_in[i];
    a.out = (float*)d_out; a.ws = (unsigned char*)d_ws;
    constexpr int NPH = 1 + 6 + 5 + 1 + 2 * NROUNDS + 1;
#if MK_MULTI
    for (int p = 0; p < NPH; ++p) { a.ph_lo = p; a.ph_hi = p + 1; hipLaunchKernelGGL(fwd_kernel, dim3(grid), dim3(NWAVES * 64), LDS_BYTES, stream, a); }
#else
    a.ph_lo = 0; a.ph_hi = NPH + 1;
    hipLaunchKernelGGL(fwd_kernel, dim3(grid), dim3(NWAVES * 64), LDS_BYTES, stream, a);
#endif
    const hipError_t le = hipPeekAtLastError();
    if (le != hipSuccess) fprintf(stderr, "kernel_launch: launch failed: %s\n", hipGetErrorName(le));
}
```
